# Optimizing an MI355X kernel written in HIP

```python
import math
import jax, jax.numpy as jnp
from jax import lax
import numpy as np

D_MODEL = 2048
BATCH = 4
SEQ = 2048
DEPTH = 1

D_MIX = D_MODEL
SSM_D_INNER = D_MIX // 2
SSM_HEAD_DIM = 64
SSM_N_HEADS = SSM_D_INNER // SSM_HEAD_DIM
SSM_N_GROUPS = 4
SSM_D_STATE = 128
SSM_CONV = 4
SSM_CHUNK = 128
SSM_CONV_DIM = SSM_D_INNER + 2 * SSM_N_GROUPS * SSM_D_STATE
ATTN_WIDTH = D_MIX - SSM_D_INNER
ATTN_HEAD_DIM = 64
ATTN_N_HEADS = ATTN_WIDTH // ATTN_HEAD_DIM
ATTN_N_KV = 2
WINDOW = 128
ATTN_BLOCK = WINDOW
D_FF = 4 * D_MODEL
EPS = 1e-5

IN_PROJ_DIM = SSM_D_INNER + SSM_CONV_DIM + SSM_N_HEADS + ATTN_WIDTH + 2 * ATTN_N_KV * ATTN_HEAD_DIM

kernel_name = 'hymba_ssd_swa_sink_hybrid'


def rmsnorm(x, g):
    xf = x.astype(jnp.float32)
    y = xf * lax.rsqrt(jnp.mean(xf * xf, axis=-1, keepdims=True) + EPS)
    return (y * g.astype(jnp.float32)).astype(x.dtype)


def causal_dwconv(u, w, b):
    K, C = w.shape
    out = lax.conv_general_dilated(
        u, w[:, None, :].astype(u.dtype), window_strides=(1,), padding=[(K - 1, 0)],
        dimension_numbers=('NWC', 'WIO', 'NWC'), feature_group_count=C)
    return out + b.astype(u.dtype)


def ssd_chunked(x, dt, A, Bm, Cm):
    b, L, H, P = x.shape
    G, N = Bm.shape[-2:]
    R = H // G
    Q = SSM_CHUNK
    nc = L // Q
    f32 = jnp.float32
    Xd = (x.astype(f32) * dt[..., None]).reshape(b, nc, Q, G, R, P)
    a = jnp.moveaxis((dt * A).reshape(b, nc, Q, G, R), 2, -1)
    a_cs = jnp.cumsum(a, axis=-1)
    Bc = Bm.astype(f32).reshape(b, nc, Q, G, N)
    Cc = Cm.astype(f32).reshape(b, nc, Q, G, N)
    idx = jnp.arange(Q)
    causal = idx[:, None] >= idx[None, :]
    seg = a_cs[..., :, None] - a_cs[..., None, :]
    Lmat = jnp.exp(jnp.where(causal, seg, -jnp.inf))
    CB = jnp.einsum('bclgn,bcsgn->bcgls', Cc, Bc)
    y_diag = jnp.einsum('bcgls,bcgrls,bcsgrp->bclgrp', CB, Lmat, Xd)
    decay_to_end = jnp.exp(a_cs[..., -1:] - a_cs)
    chunk_states = jnp.einsum('bcsgn,bcgrs,bcsgrp->bcgrpn', Bc, decay_to_end, Xd)
    chunk_decay = jnp.exp(a_cs[..., -1])

    def step(h, inp):
        s_c, d_c = inp
        return d_c[..., None, None] * h + s_c, h

    h0 = jnp.zeros((b, G, R, P, N), f32)
    _, prev = lax.scan(step, h0, (jnp.moveaxis(chunk_states, 1, 0), jnp.moveaxis(chunk_decay, 1, 0)))
    prev = jnp.moveaxis(prev, 0, 1)
    y_off = jnp.einsum('bclgn,bcgrpn,bcgrl->bclgrp', Cc, prev, jnp.exp(a_cs))
    return (y_diag + y_off).reshape(b, L, H, P)


def ssd_mixer(z, xBC, dt_raw, conv_w, conv_b, dt_bias, A_log, D_skip, norm_g):
    b, L, _ = z.shape
    f32 = jnp.float32
    xBC = jax.nn.silu(causal_dwconv(xBC, conv_w, conv_b))
    GN = SSM_N_GROUPS * SSM_D_STATE
    xs = xBC[..., :SSM_D_INNER].reshape(b, L, SSM_N_HEADS, SSM_HEAD_DIM)
    Bm = xBC[..., SSM_D_INNER:SSM_D_INNER + GN].reshape(b, L, SSM_N_GROUPS, SSM_D_STATE)
    Cm = xBC[..., SSM_D_INNER + GN:].reshape(b, L, SSM_N_GROUPS, SSM_D_STATE)
    dt = jax.nn.softplus(dt_raw.astype(f32) + dt_bias.astype(f32))
    A = -jnp.exp(A_log.astype(f32))
    y = ssd_chunked(xs, dt, A, Bm, Cm)
    y = y + xs.astype(f32) * D_skip.astype(f32)[:, None]
    y = y.reshape(b, L, SSM_D_INNER) * jax.nn.silu(z.astype(f32))
    yg = y.reshape(b, L, SSM_N_GROUPS, SSM_D_INNER // SSM_N_GROUPS)
    yg = yg * lax.rsqrt(jnp.mean(yg * yg, axis=-1, keepdims=True) + EPS)
    y = yg.reshape(b, L, SSM_D_INNER) * norm_g.astype(f32)
    return y.astype(z.dtype)


def swa_sink_attention(q, k, v, sinks):
    b, L, Hq, Dh = q.shape
    Hkv = k.shape[2]
    R = Hq // Hkv
    Qb = ATTN_BLOCK
    nb = L // Qb
    f32 = jnp.float32
    qb = q.astype(f32).reshape(b, nb, Qb, Hkv, R, Dh)
    pad = jnp.zeros((b, Qb, Hkv, Dh), f32)
    kp = jnp.concatenate([pad, k.astype(f32)], axis=1).reshape(b, nb + 1, Qb, Hkv, Dh)
    vp = jnp.concatenate([pad, v.astype(f32)], axis=1).reshape(b, nb + 1, Qb, Hkv, Dh)
    kb = jnp.concatenate([kp[:, :-1], kp[:, 1:]], axis=2)
    vb = jnp.concatenate([vp[:, :-1], vp[:, 1:]], axis=2)
    s = jnp.einsum('bnqhrd,bnkhd->bnhrqk', qb, kb) * (Dh ** -0.5)
    i = jnp.arange(Qb)[:, None]
    j = jnp.arange(2 * Qb)[None, :]
    n = jnp.arange(nb)[:, None, None]
    diff = Qb + i - j
    valid = (diff >= 0) & (diff < WINDOW) & ((n - 1) * Qb + j >= 0)
    s = jnp.where(valid[None, :, None, None], s, -jnp.inf)
    sink = sinks.astype(f32).reshape(Hkv, R)[None, None, :, :, None, None]
    m = jnp.maximum(jnp.max(s, axis=-1, keepdims=True), sink)
    p = jnp.exp(s - m)
    denom = jnp.sum(p, axis=-1, keepdims=True) + jnp.exp(sink - m)
    o = jnp.einsum('bnhrqk,bnkhd->bnqhrd', p / denom, vb)
    return o.reshape(b, L, Hq * Dh).astype(q.dtype)


def setup_inputs(seed: int = 0) -> dict:
    key = jax.random.key(seed)
    ks = jax.random.split(key, 16)
    f32 = jnp.float32

    def nrm(k, shape, scale):
        return jax.random.normal(k, shape, f32) * scale

    x = nrm(ks[0], (BATCH, SEQ, D_MODEL), 1.0)
    mix_norm_g = 1.0 + nrm(ks[1], (DEPTH, D_MODEL), 0.02)
    w_in = nrm(ks[2], (DEPTH, D_MODEL, IN_PROJ_DIM), D_MODEL ** -0.5)
    conv_w = nrm(ks[3], (DEPTH, SSM_CONV, SSM_CONV_DIM), SSM_CONV ** -0.5)
    conv_b = nrm(ks[4], (DEPTH, SSM_CONV_DIM), 0.01)
    dt0 = jnp.exp(jax.random.uniform(ks[5], (DEPTH, SSM_N_HEADS), f32, math.log(1e-3), math.log(1e-1)))
    dt_bias = dt0 + jnp.log(-jnp.expm1(-dt0))
    A_log = jnp.log(jax.random.uniform(ks[6], (DEPTH, SSM_N_HEADS), f32, 1.0, 16.0))
    D_skip = 1.0 + nrm(ks[7], (DEPTH, SSM_N_HEADS), 0.02)
    ssm_norm_g = 1.0 + nrm(ks[8], (DEPTH, SSM_D_INNER), 0.02)
    attn_sinks = nrm(ks[9], (DEPTH, ATTN_N_HEADS), 0.5)
    attn_out_norm_g = 1.0 + nrm(ks[10], (DEPTH, ATTN_WIDTH), 0.02)
    w_out = nrm(ks[11], (DEPTH, D_MIX, D_MODEL), D_MIX ** -0.5)
    mlp_norm_g = 1.0 + nrm(ks[12], (DEPTH, D_MODEL), 0.02)
    w_up = nrm(ks[13], (DEPTH, D_MODEL, D_FF), D_MODEL ** -0.5)
    w_down = nrm(ks[14], (DEPTH, D_FF, D_MODEL), D_FF ** -0.5)
    final_norm_g = 1.0 + nrm(ks[15], (D_MODEL,), 0.02)
    return {'x': x, 'mix_norm_g': mix_norm_g, 'w_in': w_in, 'conv_w': conv_w, 'conv_b': conv_b,
            'dt_bias': dt_bias, 'A_log': A_log, 'D_skip': D_skip, 'ssm_norm_g': ssm_norm_g,
            'attn_sinks': attn_sinks, 'attn_out_norm_g': attn_out_norm_g, 'w_out': w_out,
            'mlp_norm_g': mlp_norm_g, 'w_up': w_up, 'w_down': w_down, 'final_norm_g': final_norm_g}


def reference(x, mix_norm_g, w_in, conv_w, conv_b, dt_bias, A_log, D_skip, ssm_norm_g,
              attn_sinks, attn_out_norm_g, w_out, mlp_norm_g, w_up, w_down, final_norm_g):
    b, L, _ = x.shape
    KVW = ATTN_N_KV * ATTN_HEAD_DIM
    splits = [SSM_D_INNER, SSM_D_INNER + SSM_CONV_DIM, SSM_D_INNER + SSM_CONV_DIM + SSM_N_HEADS,
              SSM_D_INNER + SSM_CONV_DIM + SSM_N_HEADS + ATTN_WIDTH,
              SSM_D_INNER + SSM_CONV_DIM + SSM_N_HEADS + ATTN_WIDTH + KVW]
    for l in range(DEPTH):
        h = rmsnorm(x, mix_norm_g[l])
        proj = jnp.einsum('bsd,de->bse', h, w_in[l])
        z, xBC, dt_raw, q, k, v = jnp.split(proj, splits, axis=-1)
        y_ssm = ssd_mixer(z, xBC, dt_raw, conv_w[l], conv_b[l], dt_bias[l], A_log[l],
                          D_skip[l], ssm_norm_g[l])
        y_att = swa_sink_attention(q.reshape(b, L, ATTN_N_HEADS, ATTN_HEAD_DIM),
                                   k.reshape(b, L, ATTN_N_KV, ATTN_HEAD_DIM),
                                   v.reshape(b, L, ATTN_N_KV, ATTN_HEAD_DIM), attn_sinks[l])
        y_att = rmsnorm(y_att, attn_out_norm_g[l])
        y = jnp.concatenate([y_ssm, y_att.astype(y_ssm.dtype)], axis=-1)
        x = x + jnp.einsum('bse,ed->bsd', y, w_out[l])
        h = rmsnorm(x, mlp_norm_g[l])
        u = jnp.einsum('bsd,df->bsf', h, w_up[l])
        x = x + jnp.einsum('bsf,fd->bsd', jnp.square(jax.nn.relu(u)), w_down[l])
    return rmsnorm(x, final_norm_g)
```

```cpp
#include <hip/hip_runtime.h>
#include <hip/hip_cooperative_groups.h>
#include <cstdio>
#include <cstdint>
namespace cg = cooperative_groups;

#ifndef MK_PROBE_PHASE
#define MK_PROBE_PHASE -1
#endif

#define DI __device__ __forceinline__
#define LAS __attribute__((address_space(3)))
typedef unsigned short bf16;
typedef short bf16x8 __attribute__((ext_vector_type(8)));
typedef float f32x4 __attribute__((ext_vector_type(4)));
typedef float f32x2 __attribute__((ext_vector_type(2)));
typedef unsigned u32x4 __attribute__((ext_vector_type(4)));
typedef unsigned u32x2 __attribute__((ext_vector_type(2)));
typedef float f32x16 __attribute__((ext_vector_type(16)));
typedef __bf16 bf16x2_t __attribute__((ext_vector_type(2)));

constexpr int M = 8192, D = 2048, SEQ = 2048, NBATCH = 4;
constexpr int NIN = 4368, NPROJ = 4352;
constexpr int PZ = 0, PXBC = 1024, PQ = 3072, PK = 4096, PV = 4224;
constexpr int DT_COL = 3072;
constexpr int NH = 16, HD = 64, NG = 4, NS = 128, DINNER = 1024, CONVD = 2048;
constexpr int FF = 8192;
constexpr float EPS = 1e-5f;

constexpr size_t MiB = 1u << 20;
constexpr size_t WS_WUP = 2 * MiB, WS_WDN = 34 * MiB, WS_XN = 66 * MiB;
constexpr size_t WS_SSQ1 = 98 * MiB, WS_SSQ2 = 98 * MiB + 256 * 1024, WS_DT = 98 * MiB + 512 * 1024;
constexpr size_t WS_H = 100 * MiB;
constexpr size_t WS_WIN = 100 * MiB, WS_WDT = 117 * MiB, WS_WOUT = 118 * MiB, WS_PROJ = 126 * MiB, WS_Y = 194 * MiB;
constexpr size_t WS_MISC = 228 * MiB;

constexpr int RING_BYTES = 131072, XLDS_OFF = RING_BYTES, LDS_BYTES = 149504 + 64, MISC_OFF = 149504;

DI float bf2f(bf16 v) { return __uint_as_float(((unsigned)v) << 16); }
DI unsigned f2bf(float f) { unsigned u = __float_as_uint(f); return (u + 0x7fffu + ((u >> 16) & 1u)) >> 16; }
DI unsigned pk2(float lo, float hi) { f32x2 v = {lo, hi}; bf16x2_t b = __builtin_convertvector(v, bf16x2_t); return __builtin_bit_cast(unsigned, b); }
DI float wave_sum(float v) {
#pragma unroll
    for (int o = 1; o < 64; o <<= 1) v += __shfl_xor(v, o);
    return v;
}
DI float silu_f(float x) { return x * __builtin_amdgcn_rcpf(1.f + __expf(-x)); }
DI float softplus_f(float x) { return x > 20.f ? x : log1pf(__expf(x)); }

namespace pg8 {
constexpr int BM = 256, BK = 64, HALF = 128, HTB = HALF * BK * 2, NXCD = 8, WGM = 8;
__host__ __device__ __forceinline__ int lds_byte(int r, int c) { const int st = (r >> 4) * 2 + (c >> 5), rr = r & 15, cc = c & 31, ob = rr * 64 + cc * 2; return st * 1024 + (ob ^ (((ob >> 9) & 1) << 5)); }
__host__ __device__ __forceinline__ void stage_rc(int b, int& R, int& C) { const int st = b / 1024, sb = b % 1024, swz = sb ^ (((sb >> 9) & 1) << 5); R = (st >> 1) * 16 + swz / 64; C = (st & 1) * 32 + (swz % 64) / 2; }
__host__ __device__ __forceinline__ int perm32(int rho) { const int n = rho >> 4, i = rho & 15; return 8 * (i >> 2) + 4 * n + (i & 3); }

struct Unit { int pm, pn; };
struct Gemm { const bf16* A; const bf16* Bt; int M, N, K; };
struct StaticOrder {
    int nM, nN, nwg, G, c;
    DI void init(int M_, int N_, int G_, int c_) { nM = M_ / BM; nN = N_ / BM; nwg = nM * nN; G = G_; c = c_; rebal = 0; }
    int rebal;
    DI bool next(int i, Unit& u) const {
        long L = (long)i * G + c;
        if (rebal) { if (i == 0) L = c; else if (i == 1) { if (c >= 144) return false; L = 256 + c; } else if (i == 2) { if (c >= 144) return false; L = 400 + c; } else return false; }
        if (L >= nwg) return false;
        int wgid = (int)L; { const int q = nwg / NXCD, r = nwg % NXCD, xcd = wgid % NXCD, off = wgid / NXCD; wgid = (xcd < r ? xcd * (q + 1) : r * (q + 1) + (xcd - r) * q) + off; }
        const int nig = WGM * nN, gid = wgid / nig, fm = gid * WGM, gsz = (nM - fm) < WGM ? (nM - fm) : WGM;
        u.pm = fm + ((wgid % nig) % gsz); u.pn = (wgid % nig) / gsz; return true;
    }
};

template <class Epi>
DI void gemm_phase(LAS unsigned char* lds, const Gemm g, const StaticOrder& S, const Epi& E) {
    const int tid = threadIdx.x, wid = __builtin_amdgcn_readfirstlane(tid >> 6), lane = tid & 63, wr = wid >> 2, wc = wid & 3, fr = lane & 15, fq = lane >> 4;
    const int K = g.K, nt = K / BK;
    unsigned voffA[2], voffB[2];
#pragma unroll
    for (int i = 0; i < 2; ++i) { int R, C; stage_rc(tid * 16 + i * 8192, R, C); const int Rb = (R & ~31) + perm32(R & 31);
        voffA[i] = (unsigned)(R * K + C) * 2u; voffB[i] = (unsigned)(Rb * K + C) * 2u; }
    const size_t kstep = (size_t)(BK * 2);
    const size_t hstep = (size_t)HALF * K * 2;
    const size_t tstep = 2 * hstep;
    const unsigned ldsw = (unsigned)wid * 1024u;
    const int aoff = lds_byte(wr * 64 + fr, fq * 8), boff = lds_byte(wc * 32 + fr, fq * 8);
#define PG8_SA(b, h) (((b) * 2 + (h)) * HTB)
#define PG8_SB(b, h) ((4 + (b) * 2 + (h)) * HTB)
#define PG8_STAGE(bufoff, gbase, voff) do { _Pragma("unroll") for (int _i = 0; _i < 2; ++_i) \
        __builtin_amdgcn_global_load_lds((const unsigned*)((const char*)(gbase) + (voff)[_i]), (LAS unsigned*)(lds + (bufoff) + ldsw + _i * 8192), 16, 0, 0); } while (0)
#define PG8_LDA(dst, b, h) do { _Pragma("unroll") for (int m = 0; m < 4; ++m) _Pragma("unroll") for (int k = 0; k < 2; ++k) dst[m][k] = *(const LAS bf16x8*)(lds + PG8_SA(b, h) + aoff + m * 2048 + k * 1024); } while (0)
#define PG8_LDB(dst, b, h) do { _Pragma("unroll") for (int n = 0; n < 2; ++n) _Pragma("unroll") for (int k = 0; k < 2; ++k) dst[n][k] = *(const LAS bf16x8*)(lds + PG8_SB(b, h) + boff + n * 2048 + k * 1024); } while (0)
#define PG8_MMA(ai, bj, At, Bt) do { __builtin_amdgcn_s_setprio(1); _Pragma("unroll") for (int m = 0; m < 4; ++m) _Pragma("unroll") for (int n = 0; n < 2; ++n) _Pragma("unroll") for (int k = 0; k < 2; ++k) \
        acc[ai][bj][m][n] = __builtin_amdgcn_mfma_f32_16x16x32_bf16(Bt[n][k], At[m][k], acc[ai][bj][m][n], 0, 0, 0); __builtin_amdgcn_s_setprio(0); } while (0)
#define PG8_WAIT_V(n) asm volatile("s_waitcnt vmcnt(" #n ")" ::: "memory")
#define PG8_WAIT_L(n) asm volatile("s_waitcnt lgkmcnt(" #n ")" ::: "memory")
#define PG8_BAR __builtin_amdgcn_s_barrier()
#define PG8_SCHED __builtin_amdgcn_sched_barrier(0)
    Unit cur, nxt; int ui = 0;
    if (!S.next(0, cur)) return;
    f32x4 acc[2][2][4][2];
#pragma unroll
    for (int a = 0; a < 2; ++a)
#pragma unroll
        for (int b = 0; b < 2; ++b)
#pragma unroll
            for (int m = 0; m < 4; ++m)
#pragma unroll
                for (int n = 0; n < 2; ++n) acc[a][b][m][n] = (f32x4){0.f, 0.f, 0.f, 0.f};
    bf16x8 At[4][2], B0[2][2], B1[2][2];
    const char* cA = (const char*)g.A + (size_t)cur.pm * tstep; const char* cB = (const char*)g.Bt + (size_t)cur.pn * tstep;
    PG8_STAGE(PG8_SB(0, 0), cB, voffB); PG8_STAGE(PG8_SB(0, 1), cB + hstep, voffB); PG8_STAGE(PG8_SA(0, 0), cA, voffA); PG8_STAGE(PG8_SA(0, 1), cA + hstep, voffA);
    if (wr == 1) PG8_BAR;
    PG8_WAIT_V(2); PG8_BAR;
    PG8_STAGE(PG8_SB(1, 0), cB + kstep, voffB); PG8_STAGE(PG8_SA(1, 0), cA + kstep, voffA); PG8_STAGE(PG8_SB(1, 1), cB + hstep + kstep, voffB);
    PG8_WAIT_V(6); PG8_BAR;
    for (;;) {
        const bool has_next = S.next(ui + 1, nxt);
        const char* nA = has_next ? (const char*)g.A + (size_t)nxt.pm * tstep : cA; const char* nB = has_next ? (const char*)g.Bt + (size_t)nxt.pn * tstep : cB;
        for (int t = 0; t < nt; t += 2) {
            const bool last = (t == nt - 2);
            const char* a1 = cA + (size_t)(t + 1) * kstep;
            const char* a2 = last ? nA : cA + (size_t)(t + 2) * kstep; const char* b2 = last ? nB : cB + (size_t)(t + 2) * kstep;
            const char* a3 = a2 + kstep; const char* b3 = b2 + kstep;
            PG8_LDB(B0, 0, 0); PG8_LDB(B1, 0, 1); PG8_SCHED; PG8_LDA(At, 0, 0); PG8_STAGE(PG8_SA(1, 1), a1 + hstep, voffA);
            PG8_WAIT_V(8); PG8_WAIT_L(0); PG8_BAR; PG8_MMA(0, 0, At, B0); PG8_MMA(0, 1, At, B1); PG8_BAR; PG8_SCHED;
            PG8_LDA(At, 0, 1); PG8_STAGE(PG8_SB(0, 0), b2, voffB); PG8_STAGE(PG8_SB(0, 1), b2 + hstep, voffB); PG8_STAGE(PG8_SA(0, 0), a2, voffA);
            PG8_WAIT_V(8); PG8_WAIT_L(0); PG8_BAR; PG8_MMA(1, 0, At, B0); PG8_MMA(1, 1, At, B1); PG8_BAR; PG8_SCHED;
            PG8_LDB(B0, 1, 0); PG8_LDB(B1, 1, 1); PG8_SCHED; PG8_LDA(At, 1, 0); PG8_STAGE(PG8_SA(0, 1), a2 + hstep, voffA);
            PG8_WAIT_V(8); PG8_WAIT_L(0); PG8_BAR; PG8_MMA(0, 0, At, B0); PG8_MMA(0, 1, At, B1); PG8_BAR; PG8_SCHED;
            PG8_LDA(At, 1, 1); PG8_STAGE(PG8_SB(1, 0), b3, voffB); PG8_STAGE(PG8_SB(1, 1), b3 + hstep, voffB); PG8_STAGE(PG8_SA(1, 0), a3, voffA);
            PG8_WAIT_V(8); PG8_WAIT_L(0); PG8_BAR; PG8_MMA(1, 0, At, B0); PG8_MMA(1, 1, At, B1); PG8_BAR; PG8_SCHED;
        }
        if (wr == 0) PG8_BAR;
        E(acc, cur, wr, wc, fr, fq, lds + XLDS_OFF);
        if (!has_next) break;
#pragma unroll
        for (int a = 0; a < 2; ++a)
#pragma unroll
            for (int b = 0; b < 2; ++b)
#pragma unroll
                for (int m = 0; m < 4; ++m)
#pragma unroll
                    for (int n = 0; n < 2; ++n) acc[a][b][m][n] = (f32x4){0.f, 0.f, 0.f, 0.f};
        cur = nxt; cA = nA; cB = nB; ++ui;
        if (wr == 1) PG8_BAR;
    }
    PG8_WAIT_V(0);
    PG8_BAR;
#undef PG8_SA
#undef PG8_SB
#undef PG8_STAGE
#undef PG8_LDA
#undef PG8_LDB
#undef PG8_MMA
#undef PG8_WAIT_V
#undef PG8_WAIT_L
#undef PG8_BAR
#undef PG8_SCHED
}

template <int MODE> struct Epi {
    bf16* O; int ldc; const float* base; float* outf; float* ssq; const float* ssq_in; unsigned* cnt;
    DI void operator()(f32x4 (&acc)[2][2][4][2], const Unit& u, int wr, int wc, int fr, int fq, LAS unsigned char* xl) const {
        const int row0 = u.pm * BM + wr * 64 + fr, col0 = u.pn * BM + wc * 32 + 8 * fq;
        if (MODE == 0) {
#pragma unroll
            for (int ai = 0; ai < 2; ++ai)
#pragma unroll
                for (int m = 0; m < 4; ++m) { bf16* rowp = O + (size_t)(row0 + ai * HALF + m * 16) * ldc + col0;
#pragma unroll
                    for (int bj = 0; bj < 2; ++bj) { const f32x4 v0 = acc[ai][bj][m][0], v1 = acc[ai][bj][m][1];
                        u32x4 w; w.x = pk2(v0[0], v0[1]); w.y = pk2(v0[2], v0[3]); w.z = pk2(v1[0], v1[1]); w.w = pk2(v1[2], v1[3]);
                        *(u32x4*)(rowp + bj * HALF) = w; } }
        } else if (MODE == 1) {
            LAS float* P = (LAS float*)xl;
#pragma unroll
            for (int ai = 0; ai < 2; ++ai)
#pragma unroll
                for (int m = 0; m < 4; ++m) { const int rl = ai * HALF + wr * 64 + m * 16 + fr; const size_t off = (size_t)(u.pm * BM + rl) * ldc + col0; float ss = 0.f;
#pragma unroll
                    for (int bj = 0; bj < 2; ++bj) {
                        const f32x4 x0 = *(const f32x4*)(base + off + bj * HALF), x1 = *(const f32x4*)(base + off + bj * HALF + 4);
                        const f32x4 v0 = acc[ai][bj][m][0] + x0, v1 = acc[ai][bj][m][1] + x1;
                        if (outf) { *(f32x4*)(outf + off + bj * HALF) = v0; *(f32x4*)(outf + off + bj * HALF + 4) = v1; }
                        if (O) { u32x4 w; w.x = pk2(v0[0], v0[1]); w.y = pk2(v0[2], v0[3]); w.z = pk2(v1[0], v1[1]); w.w = pk2(v1[2], v1[3]); *(u32x4*)(O + off + bj * HALF) = w; }
                        ss += (v0[0] * v0[0] + v0[1] * v0[1]) + (v0[2] * v0[2] + v0[3] * v0[3]) + (v1[0] * v1[0] + v1[1] * v1[1]) + (v1[2] * v1[2] + v1[3] * v1[3]);
                    }
                    ss += __shfl_xor(ss, 16); ss += __shfl_xor(ss, 32);
                    if (fq == 0) P[rl * 4 + wc] = ss; }
            asm volatile("s_waitcnt lgkmcnt(0)" ::: "memory"); __builtin_amdgcn_s_barrier(); asm volatile("" ::: "memory");
            if (threadIdx.x < 256) { const int t = threadIdx.x; const float s = (P[t * 4 + 0] + P[t * 4 + 1]) + (P[t * 4 + 2] + P[t * 4 + 3]); ssq[(size_t)(u.pm * BM + t) * 8 + u.pn] = s; }
            asm volatile("s_waitcnt lgkmcnt(0)" ::: "memory"); __builtin_amdgcn_s_barrier(); asm volatile("" ::: "memory");
        } else if (MODE == 3) {
            LAS float* P = (LAS float*)xl; LAS float* R = (LAS float*)(xl + 4096);
#pragma unroll
            for (int ai = 0; ai < 2; ++ai)
#pragma unroll
                for (int m = 0; m < 4; ++m) { const int rl = ai * HALF + wr * 64 + m * 16 + fr; const size_t off = (size_t)(u.pm * BM + rl) * ldc + col0; float ss = 0.f;
#pragma unroll
                    for (int bj = 0; bj < 2; ++bj) { const u32x4 xb = *(const u32x4*)(O + off + bj * HALF);
                        f32x4 v0 = acc[ai][bj][m][0], v1 = acc[ai][bj][m][1];
                        v0[0] += __uint_as_float(xb.x << 16); v0[1] += __uint_as_float(xb.x & 0xffff0000u); v0[2] += __uint_as_float(xb.y << 16); v0[3] += __uint_as_float(xb.y & 0xffff0000u);
                        v1[0] += __uint_as_float(xb.z << 16); v1[1] += __uint_as_float(xb.z & 0xffff0000u); v1[2] += __uint_as_float(xb.w << 16); v1[3] += __uint_as_float(xb.w & 0xffff0000u);
                        acc[ai][bj][m][0] = v0; acc[ai][bj][m][1] = v1;
                        ss += (v0[0] * v0[0] + v0[1] * v0[1]) + (v0[2] * v0[2] + v0[3] * v0[3]) + (v1[0] * v1[0] + v1[1] * v1[1]) + (v1[2] * v1[2] + v1[3] * v1[3]); }
                    ss += __shfl_xor(ss, 16); ss += __shfl_xor(ss, 32);
                    if (fq == 0) P[rl * 4 + wc] = ss; }
            asm volatile("s_waitcnt lgkmcnt(0)" ::: "memory"); __builtin_amdgcn_s_barrier(); asm volatile("" ::: "memory");
            const int t = threadIdx.x;
            if (t < 256) { const float sp = (P[t * 4 + 0] + P[t * 4 + 1]) + (P[t * 4 + 2] + P[t * 4 + 3]);
                __hip_atomic_store(ssq + (size_t)(u.pm * BM + t) * 8 + u.pn, sp, __ATOMIC_RELAXED, __HIP_MEMORY_SCOPE_AGENT); }
            asm volatile("s_waitcnt vmcnt(0)" ::: "memory"); __builtin_amdgcn_s_barrier(); asm volatile("" ::: "memory");
            if (t == 0) {
                __hip_atomic_fetch_add(cnt + 64 * u.pm, 1u, __ATOMIC_RELAXED, __HIP_MEMORY_SCOPE_AGENT);
                unsigned sp_ = 0;
                while (__hip_atomic_load(cnt + 64 * u.pm, __ATOMIC_RELAXED, __HIP_MEMORY_SCOPE_AGENT) < 8u) { __builtin_amdgcn_s_sleep(1); if (++sp_ > (1u << 22)) break; }
                __builtin_amdgcn_fence(__ATOMIC_ACQUIRE, "agent");
            }
            asm volatile("s_waitcnt vmcnt(0) lgkmcnt(0)" ::: "memory"); __builtin_amdgcn_s_barrier(); asm volatile("" ::: "memory");
            if (t < 256) { float tot = 0.f;
#pragma unroll
                for (int j = 0; j < 8; ++j) tot += __hip_atomic_load(ssq + (size_t)(u.pm * BM + t) * 8 + j, __ATOMIC_RELAXED, __HIP_MEMORY_SCOPE_AGENT);
                R[t] = rsqrtf(tot * (1.f / 2048.f) + EPS); }
            asm volatile("s_waitcnt vmcnt(0) lgkmcnt(0)" ::: "memory"); __builtin_amdgcn_s_barrier(); asm volatile("" ::: "memory");
            f32x4 gv[2][2];
#pragma unroll
            for (int bj = 0; bj < 2; ++bj) { gv[bj][0] = *(const f32x4*)(base + col0 + bj * HALF); gv[bj][1] = *(const f32x4*)(base + col0 + bj * HALF + 4); }
#pragma unroll
            for (int ai = 0; ai < 2; ++ai)
#pragma unroll
                for (int m = 0; m < 4; ++m) { const int rl = ai * HALF + wr * 64 + m * 16 + fr; const size_t off = (size_t)(u.pm * BM + rl) * ldc + col0; const float rstd = R[rl];
#pragma unroll
                    for (int bj = 0; bj < 2; ++bj) { *(f32x4*)(outf + off + bj * HALF) = acc[ai][bj][m][0] * rstd * gv[bj][0]; *(f32x4*)(outf + off + bj * HALF + 4) = acc[ai][bj][m][1] * rstd * gv[bj][1]; } }
        } else {
#pragma unroll
            for (int ai = 0; ai < 2; ++ai)
#pragma unroll
                for (int m = 0; m < 4; ++m) { const int row = row0 + ai * HALF + m * 16;
                    const f32x4 s0 = *(const f32x4*)(ssq_in + (size_t)row * 8), s1 = *(const f32x4*)(ssq_in + (size_t)row * 8 + 4);
                    const float rstd = rsqrtf(((s0[0] + s0[1]) + (s0[2] + s0[3]) + (s1[0] + s1[1]) + (s1[2] + s1[3])) * (1.f / 2048.f) + EPS);
                    bf16* rowp = O + (size_t)row * ldc + col0;
#pragma unroll
                    for (int bj = 0; bj < 2; ++bj) { f32x4 v0 = acc[ai][bj][m][0] * rstd, v1 = acc[ai][bj][m][1] * rstd;
#pragma unroll
                        for (int e = 0; e < 4; ++e) { const float a = fmaxf(v0[e], 0.f), b = fmaxf(v1[e], 0.f); v0[e] = a * a; v1[e] = b * b; }
                        u32x4 w; w.x = pk2(v0[0], v0[1]); w.y = pk2(v0[2], v0[3]); w.z = pk2(v1[0], v1[1]); w.w = pk2(v1[2], v1[3]);
                        *(u32x4*)(rowp + bj * HALF) = w; } }
        }
    }
};
}

struct Args { const float* in[16]; float* out; unsigned char* ws; int ph_lo, ph_hi; };

struct Frame {
    LAS unsigned char* lds; int tid, lane, wave, G, blk;
    const float *x, *mix_g, *w_in, *conv_w, *conv_b, *dt_bias, *A_log, *D_skip, *ssm_g, *sinks, *att_g, *w_out, *mlp_g, *w_up, *w_down, *fin_g;
    float* out; unsigned char* ws;
};

DI void p0_transpose_item(const float* W, int ldw, int src_col0, bf16* WT, int K, int dst_row0, const float* gs, LAS float* scr, int kb, int nb, int lane) {
    const int k0 = 64 * kb, n0 = 32 * nb;
    float v[32];
#pragma unroll
    for (int i = 0; i < 32; ++i) { const int kk = 2 * i + (lane >> 5); v[i] = W[(size_t)(k0 + kk) * ldw + src_col0 + n0 + (lane & 31)]; }
    if (gs) {
#pragma unroll
        for (int i = 0; i < 32; ++i) v[i] *= gs[k0 + 2 * i + (lane >> 5)]; }
#pragma unroll
    for (int i = 0; i < 32; ++i) scr[(2 * i + (lane >> 5)) * 33 + (lane & 31)] = v[i];
    asm volatile("s_waitcnt lgkmcnt(0)" ::: "memory");
    const int c = lane & 7;
#pragma unroll
    for (int j = 0; j < 4; ++j) { const int n = (lane >> 3) + 8 * j; const LAS float* s = scr + (8 * c) * 33 + n;
        u32x4 o; o.x = pk2(s[0 * 33], s[1 * 33]); o.y = pk2(s[2 * 33], s[3 * 33]); o.z = pk2(s[4 * 33], s[5 * 33]); o.w = pk2(s[6 * 33], s[7 * 33]);
        *(u32x4*)(WT + (size_t)(dst_row0 + n0 + n) * K + k0 + 8 * c) = o; }
    asm volatile("s_waitcnt lgkmcnt(0)" ::: "memory");
}
DI void p0_prologue(Frame& F) {
    LAS float* scr = (LAS float*)(F.lds + F.wave * 16384);
    const int gw = F.blk * 8 + F.wave, NGW = F.G * 8;
    bf16* Win_t = (bf16*)(F.ws + WS_WIN);
    bf16* Wdt_t = (bf16*)(F.ws + WS_WDT); bf16* XN = (bf16*)(F.ws + WS_XN);
    constexpr int I_A = 32 * 96, I_B = 32 * 40;
    constexpr int NITEMS = I_A + I_B;
    for (int it = gw; it < NITEMS; it += NGW) {
        int r = it;
        if (r < I_A) { p0_transpose_item(F.w_in, NIN, 0, Win_t, D, 0, nullptr, scr, r / 96, r % 96, F.lane); continue; } r -= I_A;
        p0_transpose_item(F.w_in, NIN, DT_COL + 16, Win_t, D, DT_COL, nullptr, scr, r / 40, r % 40, F.lane);
    }
    for (int i = F.blk * 512 + F.tid; i < 16 * D; i += F.G * 512) { const int j = i / D, k = i % D; Wdt_t[i] = (bf16)f2bf(F.w_in[(size_t)k * NIN + DT_COL + j]); }
    {
        const f32x4* gr = (const f32x4*)F.mix_g + F.lane;
        f32x4 v[8], nv[8];
        int m = gw;
        if (m < M) {
            const f32x4* xr = (const f32x4*)(F.x + (size_t)m * D) + F.lane;
#pragma unroll
            for (int j = 0; j < 8; ++j) v[j] = xr[64 * j];
        }
        for (; m < M; m += NGW) {
            const int mn = m + NGW;
            if (mn < M) { const f32x4* xr = (const f32x4*)(F.x + (size_t)mn * D) + F.lane;
#pragma unroll
                for (int j = 0; j < 8; ++j) nv[j] = xr[64 * j]; }
            float s = 0.f;
#pragma unroll
            for (int j = 0; j < 8; ++j) s += (v[j][0] * v[j][0] + v[j][1] * v[j][1]) + (v[j][2] * v[j][2] + v[j][3] * v[j][3]);
            const float rstd = rsqrtf(wave_sum(s) * (1.f / D) + EPS);
            u32x2* o8 = (u32x2*)(XN + (size_t)m * D) + F.lane;
#pragma unroll
            for (int j = 0; j < 8; ++j) { const f32x4 g = gr[64 * j]; u32x2 w; w.x = pk2(v[j][0] * rstd * g[0], v[j][1] * rstd * g[1]); w.y = pk2(v[j][2] * rstd * g[2], v[j][3] * rstd * g[3]); o8[64 * j] = w; }
#pragma unroll
            for (int j = 0; j < 8; ++j) v[j] = nv[j];
        }
    }
}

struct TrItem { const float* W; bf16* WT; const float* gs; int ldw, K, k0, n0; };
DI TrItem p0b_decode(const Frame& F, int r) {
    constexpr int I_O = 32 * 64, I_U = 32 * 256;
    TrItem t;
    if (r < I_O) { t.W = F.w_out; t.WT = (bf16*)(F.ws + WS_WOUT); t.gs = nullptr; t.ldw = D; t.K = D; t.k0 = 64 * (r / 64); t.n0 = 32 * (r % 64); return t; } r -= I_O;
    if (r < I_U) { t.W = F.w_up; t.WT = (bf16*)(F.ws + WS_WUP); t.gs = F.mlp_g; t.ldw = FF; t.K = D; t.k0 = 64 * (r / 256); t.n0 = 32 * (r % 256); return t; } r -= I_U;
    t.W = F.w_down; t.WT = (bf16*)(F.ws + WS_WDN); t.gs = nullptr; t.ldw = D; t.K = FF; t.k0 = 64 * (r / 64); t.n0 = 32 * (r % 64); return t;
}
DI void p0b_load(const TrItem& t, int lane, float (&v)[32]) {
    const float* p = t.W + (size_t)(t.k0 + (lane >> 5)) * t.ldw + t.n0 + (lane & 31);
#pragma unroll
    for (int i = 0; i < 32; ++i) v[i] = p[(size_t)(2 * i) * t.ldw];
}
DI void p0b_weights(Frame& F) {
    LAS float* scr = (LAS float*)(F.lds + F.wave * 16384);
    constexpr int NIT_ALL = 32 * 64 + 32 * 256 + 128 * 64, NIT_EARLY = 9216;
    const int lane = F.lane;
    int it, stride, NIT;
    if (F.G == 256) {
        if (F.blk < 144) return;
        it = (F.blk - 144) * 8 + F.wave; stride = 896; NIT = NIT_ALL;
    } else {
        const int nb = (F.G > 32) ? F.G - 32 : F.G, vb = (F.G > 32) ? F.blk - 32 : F.blk;
        if (vb < 0) return;
        it = vb * 8 + F.wave; stride = nb * 8; NIT = NIT_ALL;
    }
    if (it >= NIT) return;
    TrItem cur = p0b_decode(F, it);
    float v[32]; p0b_load(cur, lane, v);
    for (;;) {
        const int nx = it + stride; const bool more = nx < NIT;
        TrItem nxt = cur; float w[32];
        if (more) { nxt = p0b_decode(F, nx); p0b_load(nxt, lane, w); }
#pragma unroll
        for (int i = 0; i < 32; ++i) scr[(2 * i + (lane >> 5)) * 33 + (lane & 31)] = v[i];
        asm volatile("s_waitcnt lgkmcnt(0)" ::: "memory");
        const int c = lane & 7;
        float g8[8];
#pragma unroll
        for (int e = 0; e < 8; ++e) g8[e] = 1.f;
        if (cur.gs) { const f32x4 g0 = *(const f32x4*)(cur.gs + cur.k0 + 8 * c), g1 = *(const f32x4*)(cur.gs + cur.k0 + 8 * c + 4);
#pragma unroll
            for (int e = 0; e < 4; ++e) { g8[e] = g0[e]; g8[4 + e] = g1[e]; } }
#pragma unroll
        for (int j = 0; j < 4; ++j) { const int n = (lane >> 3) + 8 * j; const LAS float* sp = scr + (8 * c) * 33 + n;
            u32x4 o; o.x = pk2(sp[0 * 33] * g8[0], sp[1 * 33] * g8[1]); o.y = pk2(sp[2 * 33] * g8[2], sp[3 * 33] * g8[3]); o.z = pk2(sp[4 * 33] * g8[4], sp[5 * 33] * g8[5]); o.w = pk2(sp[6 * 33] * g8[6], sp[7 * 33] * g8[7]);
            *(u32x4*)(cur.WT + (size_t)(cur.n0 + n) * cur.K + cur.k0 + 8 * c) = o; }
        asm volatile("s_waitcnt lgkmcnt(0)" ::: "memory");
        if (!more) break;
        it = nx; cur = nxt;
#pragma unroll
        for (int i = 0; i < 32; ++i) v[i] = w[i];
    }
}

DI void dt_gemm(Frame& F) {
    const bf16* XN = (const bf16*)(F.ws + WS_XN); const bf16* Wdt_t = (const bf16*)(F.ws + WS_WDT); float* DT = (float*)(F.ws + WS_DT);
    const int skip = (F.G == 256) ? 144 : ((F.G > 32) ? 32 : 0);
    const int nb = F.G - skip, vb = F.blk - skip;
    if (vb < 0) return;
    LAS f32x4* part = (LAS f32x4*)F.lds;
    const int fr = F.lane & 15, fq = F.lane >> 4, rgl = F.wave >> 2, kp = F.wave & 3;
    for (int pair = vb; pair < M / 32; pair += nb) {
        const int rg = pair * 2 + rgl;
        const bf16* ap = XN + (size_t)(rg * 16 + fr) * D + kp * 512 + fq * 8; const bf16* bp = Wdt_t + (size_t)fr * D + kp * 512 + fq * 8;
        bf16x8 av[16], bv[16];
#pragma unroll
        for (int k = 0; k < 16; ++k) { av[k] = *(const bf16x8*)(ap + 32 * k); bv[k] = *(const bf16x8*)(bp + 32 * k); }
        f32x4 acc = {0.f, 0.f, 0.f, 0.f};
#pragma unroll
        for (int k = 0; k < 16; ++k) acc = __builtin_amdgcn_mfma_f32_16x16x32_bf16(av[k], bv[k], acc, 0, 0, 0);
        part[F.wave * 64 + F.lane] = acc;
        __syncthreads();
        if (kp == 0) { const f32x4 t = (part[(rgl * 4 + 0) * 64 + F.lane] + part[(rgl * 4 + 1) * 64 + F.lane]) + (part[(rgl * 4 + 2) * 64 + F.lane] + part[(rgl * 4 + 3) * 64 + F.lane]);
#pragma unroll
            for (int jj = 0; jj < 4; ++jj) DT[(size_t)(rg * 16 + fq * 4 + jj) * 16 + fr] = t[jj]; }
        __syncthreads();
    }
}


#define MFMA32(a, b, c) __builtin_amdgcn_mfma_f32_32x32x16_bf16((a), (b), (c), 0, 0, 0)
DI int crow(int i, int hi) { return (i & 3) + 8 * (i >> 2) + 4 * hi; }
DI bf16x8 pack8(const f32x16& x, int s) {
    u32x4 p; p.x = pk2(x[8 * s + 0], x[8 * s + 1]); p.y = pk2(x[8 * s + 2], x[8 * s + 3]); p.z = pk2(x[8 * s + 4], x[8 * s + 5]); p.w = pk2(x[8 * s + 6], x[8 * s + 7]);
    return __builtin_bit_cast(bf16x8, p);
}
typedef short v4i16_t __attribute__((ext_vector_type(4)));
DI v4i16_t tr4(const LAS bf16* p) { return __builtin_amdgcn_ds_read_tr16_b64_v4i16((LAS v4i16_t*)p); }
DI bf16x8 tr_frag(const LAS bf16* T, int P, int Ra, int Rb, int cbase, int lane) {
    const int q = (lane & 15) >> 2, p4 = lane & 3, blk = (lane >> 4) & 1, co = cbase + 16 * blk + 4 * p4;
    const v4i16_t lo = tr4(T + (Ra + q) * P + co), hi = tr4(T + (Rb + q) * P + co);
    return (bf16x8){lo[0], lo[1], lo[2], lo[3], hi[0], hi[1], hi[2], hi[3]};
}
constexpr int KS_PITCH = 72;
DI void attn_item(Frame& F, int item) {
    const bf16* proj = (const bf16*)(F.ws + WS_PROJ); bf16* Y = (bf16*)(F.ws + WS_Y);
    LAS bf16* Vs = (LAS bf16*)F.lds;
    LAS bf16* Ks = (LAS bf16*)(F.lds + 2 * 160 * KS_PITCH * 2);
    LAS float* red = (LAS float*)(F.lds + 4 * 160 * KS_PITCH * 2);
    const int b = item >> 6, l0 = (item & 63) * 32, t0 = b * SEQ + l0, tmin = b * SEQ;
    const int lane = F.lane, r32 = lane & 31, hi = lane >> 5, w = F.wave;
    bf16x8 qf[2][4];
#pragma unroll
    for (int hh = 0; hh < 2; ++hh)
#pragma unroll
        for (int s = 0; s < 4; ++s) qf[hh][s] = *(const bf16x8*)(proj + (size_t)(t0 + r32) * NPROJ + PQ + (2 * w + hh) * 64 + 16 * s + 8 * hi);
#pragma unroll
    for (int j = 0; j < 10; ++j) { const int rr = (j * 8 + w) * 8 + (lane >> 3), ch = lane & 7;
        const int tsel = rr / 320, rem = rr % 320, kvh = rem / 160, kk = rem % 160;
        int row = t0 - 128 + kk; if (row < tmin) row = tmin;
        const bf16x8 v = *(const bf16x8*)(proj + (size_t)row * NPROJ + (tsel ? PV : PK) + kvh * 64 + ch * 8);
        *(LAS bf16x8*)((tsel ? Vs : Ks) + (kvh * 160 + kk) * KS_PITCH + ch * 8) = v; }
    __syncthreads();
    const int kv = w >> 2;
    f32x16 o[2][2]; float ssq = 0.f;
#pragma unroll
    for (int hh = 0; hh < 2; ++hh) {
        const int hq = 2 * w + hh;
        f32x16 S[5];
#pragma unroll
        for (int tile = 0; tile < 5; ++tile) {
            const LAS bf16* kp = Ks + (kv * 160 + tile * 32 + r32) * KS_PITCH + 8 * hi;
            f32x16 a;
#pragma unroll
            for (int i = 0; i < 16; ++i) a[i] = 0.f;
#pragma unroll
            for (int s = 0; s < 4; ++s) { const bf16x8 kf = *(const LAS bf16x8*)(kp + 16 * s); a = MFMA32(kf, qf[hh][s], a); }
            S[tile] = a;
        }
        __builtin_amdgcn_sched_barrier(0);
        constexpr float SC2 = 0.125f * 1.4426950408889634f;
        const float sink = F.sinks[hq] * 1.4426950408889634f; float mx = sink;
#pragma unroll
        for (int tile = 0; tile < 5; ++tile) { const bool tv = (l0 + 32 * tile >= 128);
#pragma unroll
            for (int i = 0; i < 16; ++i) { bool valid;
                if (tile == 0) valid = tv && (crow(i, hi) > r32); else if (tile == 4) valid = (crow(i, hi) <= r32); else valid = tv;
                const float sv = valid ? S[tile][i] * SC2 : -INFINITY; S[tile][i] = sv; mx = fmaxf(mx, sv); } }
        mx = fmaxf(mx, __shfl_xor(mx, 32));
        float den = 0.f;
#pragma unroll
        for (int tile = 0; tile < 5; ++tile)
#pragma unroll
            for (int i = 0; i < 16; ++i) { const float p = __builtin_amdgcn_exp2f(S[tile][i] - mx); S[tile][i] = p; den += p; }
        den += __shfl_xor(den, 32); den += __builtin_amdgcn_exp2f(sink - mx);
        const float inv = 1.f / den;
        __builtin_amdgcn_sched_barrier(0);
        f32x16 oT[2];
#pragma unroll
        for (int dh = 0; dh < 2; ++dh)
#pragma unroll
            for (int i = 0; i < 16; ++i) oT[dh][i] = 0.f;
#pragma unroll
        for (int tile = 0; tile < 5; ++tile)
#pragma unroll
            for (int s2 = 0; s2 < 2; ++s2) { const bf16x8 pf = pack8(S[tile], s2);
#pragma unroll
                for (int dh = 0; dh < 2; ++dh) { const bf16x8 va = tr_frag(Vs + kv * 160 * KS_PITCH, KS_PITCH, tile * 32 + 16 * s2 + 4 * hi, tile * 32 + 16 * s2 + 4 * hi + 8, dh * 32, lane); oT[dh] = MFMA32(va, pf, oT[dh]); } }
#pragma unroll
        for (int dh = 0; dh < 2; ++dh)
#pragma unroll
            for (int i = 0; i < 16; ++i) { const float v = oT[dh][i] * inv; o[hh][dh][i] = v; ssq += v * v; }
        __builtin_amdgcn_sched_barrier(0);
    }
    ssq += __shfl_xor(ssq, 32);
    if (hi == 0) red[w * 32 + r32] = ssq;
    __syncthreads();
    float tot = 0.f;
#pragma unroll
    for (int ww = 0; ww < 8; ++ww) tot += red[ww * 32 + r32];
    const float rstd = rsqrtf(tot * (1.f / 1024.f) + EPS);
    LAS bf16* stg = (LAS bf16*)F.lds + w * (32 * 136);
#pragma unroll
    for (int hh = 0; hh < 2; ++hh)
#pragma unroll
        for (int dh = 0; dh < 2; ++dh)
#pragma unroll
            for (int i4 = 0; i4 < 4; ++i4) { const int cl = hh * 64 + dh * 32 + 8 * i4 + 4 * hi; const f32x4 g = *(const f32x4*)(F.att_g + w * 128 + cl);
                u32x2 wv; wv.x = pk2(o[hh][dh][4 * i4 + 0] * rstd * g[0], o[hh][dh][4 * i4 + 1] * rstd * g[1]); wv.y = pk2(o[hh][dh][4 * i4 + 2] * rstd * g[2], o[hh][dh][4 * i4 + 3] * rstd * g[3]);
                *(LAS u32x2*)(stg + r32 * 136 + cl) = wv; }
    asm volatile("s_waitcnt lgkmcnt(0)" ::: "memory");
#pragma unroll
    for (int it = 0; it < 8; ++it) { const int row = it * 4 + (lane >> 4), ch = lane & 15;
        const u32x4 v = *(const LAS u32x4*)(stg + row * 136 + ch * 8);
        *(u32x4*)(Y + (size_t)(t0 + row) * D + DINNER + w * 128 + ch * 8) = v; }
    __syncthreads();
}
constexpr int XPN = 272, BPN = 144;
constexpr int L_X = 0, L_B = 128 * XPN * 2, L_C = L_B + 128 * BPN * 2, L_TDT = L_C + 128 * BPN * 2, L_TACS = L_TDT + 2048, L_RED = L_TACS + 2048;
static_assert(L_RED + 2048 <= LDS_BYTES, "LDS map of the SSD items");
constexpr size_t WS_PREV = WS_MISC, WS_CD = WS_MISC + 16 * MiB;
DI void ssd_tables(Frame& F, int row0, int g, LAS float* tdt, LAS float* tacs) {
    const float* DT = (const float*)(F.ws + WS_DT);
    const int hh = F.wave >> 1, s = (F.wave & 1) * 64 + F.lane, h = g * 4 + hh;
    const float dtv = softplus_f(DT[(size_t)(row0 + s) * 16 + h] + F.dt_bias[h]);
    float v = dtv * (-__expf(F.A_log[h]));
#pragma unroll
    for (int o = 1; o < 64; o <<= 1) { const float u = __shfl_up(v, o); if (F.lane >= o) v += u; }
    tdt[hh * 128 + s] = dtv; if (!(F.wave & 1)) tacs[hh * 128 + s] = v;
    __syncthreads();
    if (F.wave & 1) tacs[hh * 128 + s] = v + tacs[hh * 128 + 63];
    __syncthreads();
}
struct ConvRegs { bf16x8 v[19]; float wk[4][8]; float bb[8]; };
template <bool STATE> DI void conv_issue(Frame& F, const bf16* proj, int row0, int l00, int g, ConvRegs& R) {
    const int ck = F.lane, seg = F.wave;
    int ch0;
    if (ck < 32) ch0 = g * 256 + ck * 8; else if (ck < 48) ch0 = DINNER + g * 128 + (ck - 32) * 8; else ch0 = DINNER + 512 + g * 128 + (ck - 48) * 8;
    const bf16* src = proj + (size_t)(row0 + seg * 16 - 3) * NPROJ + PXBC + ch0;
#pragma unroll
    for (int r = 0; r < 19; ++r) { if (l00 + seg * 16 - 3 + r >= 0) R.v[r] = *(const bf16x8*)(src + (size_t)r * NPROJ); else R.v[r] = (bf16x8){0, 0, 0, 0, 0, 0, 0, 0}; }
#pragma unroll
    for (int k = 0; k < 4; ++k) { const f32x4 w0 = *(const f32x4*)(F.conv_w + k * CONVD + ch0), w1 = *(const f32x4*)(F.conv_w + k * CONVD + ch0 + 4);
#pragma unroll
        for (int e = 0; e < 4; ++e) { R.wk[k][e] = w0[e]; R.wk[k][4 + e] = w1[e]; } }
    { const f32x4 b0 = *(const f32x4*)(F.conv_b + ch0), b1 = *(const f32x4*)(F.conv_b + ch0 + 4);
#pragma unroll
      for (int e = 0; e < 4; ++e) { R.bb[e] = b0[e]; R.bb[4 + e] = b1[e]; } }
}
template <bool STATE> DI void conv_compute(Frame& F, const ConvRegs& R, const LAS float* tdt, const LAS float* tacs) {
    const int ck = F.lane, seg = F.wave;
    if (STATE && ck >= 48) return;
    int pitch, ccol, loff;
    if (ck < 32) { pitch = XPN; ccol = ck * 8; loff = L_X; }
    else if (ck < 48) { pitch = BPN; ccol = (ck - 32) * 8; loff = L_B; }
    else { pitch = BPN; ccol = (ck - 48) * 8; loff = L_C; }
    LAS bf16* dst = (LAS bf16*)(F.lds + loff);
    const int hh = ck >> 3;
#pragma unroll
    for (int i = 0; i < 16; ++i) { const int sr = seg * 16 + i; float o[8];
#pragma unroll
        for (int e = 0; e < 8; ++e) { float a = R.bb[e];
#pragma unroll
            for (int k = 0; k < 4; ++k) a += R.wk[k][e] * bf2f((bf16)R.v[i + k][e]);
            o[e] = silu_f(a); }
        if (STATE && ck < 32) { const float sc = tdt[hh * 128 + sr] * __expf(tacs[hh * 128 + 127] - tacs[hh * 128 + sr]);
#pragma unroll
            for (int e = 0; e < 8; ++e) o[e] *= sc; }
        u32x4 wv; wv.x = pk2(o[0], o[1]); wv.y = pk2(o[2], o[3]); wv.z = pk2(o[4], o[5]); wv.w = pk2(o[6], o[7]);
        *(LAS u32x4*)(dst + sr * pitch + ccol) = wv; }
}
DI void ssd_front(Frame& F, int item, f32x16 (&yd)[2][2]) {
    const bf16* proj = (const bf16*)(F.ws + WS_PROJ); float* ST = F.out; float* CD = (float*)(F.ws + WS_CD);
    const LAS bf16* Xs = (const LAS bf16*)(F.lds + L_X); const LAS bf16* Bs = (const LAS bf16*)(F.lds + L_B); const LAS bf16* Cs = (const LAS bf16*)(F.lds + L_C);
    LAS float* tdt = (LAS float*)(F.lds + L_TDT); LAS float* tacs = (LAS float*)(F.lds + L_TACS); LAS float* tw = (LAS float*)(F.lds + L_RED);
    const int b = item >> 6, c = (item >> 2) & 15, g = item & 3, row0 = b * SEQ + c * 128, l00 = c * 128;
    const int lane = F.lane, r32 = lane & 31, hi = lane >> 5, w = F.wave;
    ConvRegs cr; conv_issue<false>(F, proj, row0, l00, g, cr);
    ssd_tables(F, row0, g, tdt, tacs);
    { const int t = F.tid; tw[t] = tdt[t] * __expf(tacs[(t & ~127) + 127] - tacs[t]); }
    conv_compute<false>(F, cr, tdt, tacs);
    __syncthreads();
    const int hh = w >> 1, h = g * 4 + hh;
    {
        const int pt = w & 1;
        f32x16 acc[4];
#pragma unroll
        for (int nt = 0; nt < 4; ++nt)
#pragma unroll
            for (int i = 0; i < 16; ++i) acc[nt][i] = 0.f;
#pragma unroll
        for (int ks = 0; ks < 8; ++ks) { const bf16x8 ax = tr_frag(Xs, XPN, 16 * ks + 8 * hi, 16 * ks + 8 * hi + 4, hh * 64 + pt * 32, lane);
            const f32x4 w0 = *(const LAS f32x4*)(tw + hh * 128 + 16 * ks + 8 * hi), w1 = *(const LAS f32x4*)(tw + hh * 128 + 16 * ks + 8 * hi + 4);
            u32x4 pa; pa.x = pk2(bf2f((bf16)ax[0]) * w0[0], bf2f((bf16)ax[1]) * w0[1]); pa.y = pk2(bf2f((bf16)ax[2]) * w0[2], bf2f((bf16)ax[3]) * w0[3]);
            pa.z = pk2(bf2f((bf16)ax[4]) * w1[0], bf2f((bf16)ax[5]) * w1[1]); pa.w = pk2(bf2f((bf16)ax[6]) * w1[2], bf2f((bf16)ax[7]) * w1[3]);
            const bf16x8 af = __builtin_bit_cast(bf16x8, pa);
#pragma unroll
            for (int nt = 0; nt < 4; ++nt) { const bf16x8 bfr = tr_frag(Bs, BPN, 16 * ks + 8 * hi, 16 * ks + 8 * hi + 4, nt * 32, lane); acc[nt] = MFMA32(af, bfr, acc[nt]); } }
        float* stp = ST + (size_t)((b * 16 + c) * 16 + h) * 8192;
#pragma unroll
        for (int nt = 0; nt < 4; ++nt)
#pragma unroll
            for (int i = 0; i < 16; ++i) stp[(pt * 32 + crow(i, hi)) * 128 + nt * 32 + r32] = acc[nt][i];
        if (F.tid < 4) CD[(b * 16 + c) * 16 + g * 4 + F.tid] = __expf(tacs[F.tid * 128 + 127]);
    }
    const int pr = w & 1;
#pragma unroll
    for (int li = 0; li < 2; ++li) {
        const int lt = (li == 0) ? pr : 3 - pr, l = lt * 32 + r32;
        bf16x8 cf[8];
#pragma unroll
        for (int ks = 0; ks < 8; ++ks) cf[ks] = *(const LAS bf16x8*)(Cs + l * BPN + 16 * ks + 8 * hi);
        f32x16 acc[2];
#pragma unroll
        for (int pt = 0; pt < 2; ++pt)
#pragma unroll
            for (int i = 0; i < 16; ++i) acc[pt][i] = 0.f;
        const float al = tacs[hh * 128 + l];
#pragma unroll 1
        for (int st = 0; st <= lt; ++st) {
            f32x16 gT;
#pragma unroll
            for (int i = 0; i < 16; ++i) gT[i] = 0.f;
#pragma unroll
            for (int ks = 0; ks < 8; ++ks) { const bf16x8 bfr = *(const LAS bf16x8*)(Bs + (st * 32 + r32) * BPN + 16 * ks + 8 * hi); gT = MFMA32(bfr, cf[ks], gT); }
#pragma unroll
            for (int i = 0; i < 16; ++i) { const int s = st * 32 + crow(i, hi); const float v = gT[i] * __expf(al - tacs[hh * 128 + s]) * tdt[hh * 128 + s]; gT[i] = (s > l) ? 0.f : v; }
#pragma unroll
            for (int s2 = 0; s2 < 2; ++s2) { const bf16x8 mf = pack8(gT, s2);
#pragma unroll
                for (int pt = 0; pt < 2; ++pt) { const bf16x8 xa = tr_frag(Xs, XPN, st * 32 + 16 * s2 + 4 * hi, st * 32 + 16 * s2 + 4 * hi + 8, hh * 64 + pt * 32, lane); acc[pt] = MFMA32(xa, mf, acc[pt]); } }
        }
        yd[li][0] = acc[0]; yd[li][1] = acc[1];
        __builtin_amdgcn_sched_barrier(0);
    }
}
DI void ssd_scan(Frame& F) {
    const float* ST = F.out; const float* CD = (const float*)(F.ws + WS_CD); bf16* PREV = (bf16*)(F.ws + WS_PREV);
    for (int idx = F.blk * 512 + F.tid; idx < NBATCH * NH * 64 * 32; idx += F.G * 512) {
        const int n4 = idx & 31, p = (idx >> 5) & 63, h = (idx >> 11) & 15, b = idx >> 15;
        const size_t base0 = (size_t)(b * 256 + h) * 8192 + p * 128 + n4 * 4;
        f32x4 sv[15]; float d[15];
#pragma unroll
        for (int c = 0; c < 15; ++c) { sv[c] = *(const f32x4*)(ST + base0 + (size_t)c * 16 * 8192); d[c] = CD[(b * 16 + c) * 16 + h]; }
        f32x4 st = {0.f, 0.f, 0.f, 0.f};
#pragma unroll
        for (int c = 0; c < 16; ++c) { u32x2 wv; wv.x = pk2(st[0], st[1]); wv.y = pk2(st[2], st[3]); *(u32x2*)(PREV + base0 + (size_t)c * 16 * 8192) = wv;
            if (c < 15) st = st * d[c] + sv[c]; }
    }
}
DI void ssd_back(Frame& F, int item, f32x16 (&yd)[2][2]) {
    const bf16* proj = (const bf16*)(F.ws + WS_PROJ); bf16* Y = (bf16*)(F.ws + WS_Y); const bf16* PREV = (const bf16*)(F.ws + WS_PREV);
    const LAS bf16* Xs = (const LAS bf16*)(F.lds + L_X); const LAS bf16* Cs = (const LAS bf16*)(F.lds + L_C);
    LAS float* tacs = (LAS float*)(F.lds + L_TACS); LAS float* red = (LAS float*)(F.lds + L_RED);
    const int b = item >> 6, c = (item >> 2) & 15, g = item & 3, row0 = b * SEQ + c * 128;
    const int lane = F.lane, r32 = lane & 31, hi = lane >> 5, w = F.wave;
    const int hh = w >> 1, pr = w & 1, h = g * 4 + hh;
    const bf16* prevp = PREV + (size_t)((b * 16 + c) * 16 + h) * 8192;
    const float Dk = F.D_skip[h];
    bf16x8 pf[2][8];
#pragma unroll
    for (int ks = 0; ks < 8; ++ks)
#pragma unroll
        for (int pt = 0; pt < 2; ++pt) pf[pt][ks] = *(const bf16x8*)(prevp + (pt * 32 + r32) * 128 + 16 * ks + 8 * hi);
#pragma unroll
    for (int li = 0; li < 2; ++li) {
        const int lt = (li == 0) ? pr : 3 - pr, l = lt * 32 + r32;
        u32x2 zz[2][4];
#pragma unroll
        for (int pt = 0; pt < 2; ++pt)
#pragma unroll
            for (int i4 = 0; i4 < 4; ++i4) zz[pt][i4] = *(const u32x2*)(proj + (size_t)(row0 + l) * NPROJ + PZ + h * 64 + pt * 32 + 8 * i4 + 4 * hi);
        f32x16 acc[2];
#pragma unroll
        for (int pt = 0; pt < 2; ++pt)
#pragma unroll
            for (int i = 0; i < 16; ++i) acc[pt][i] = 0.f;
#pragma unroll
        for (int ks = 0; ks < 8; ++ks) { const bf16x8 cfk = *(const LAS bf16x8*)(Cs + l * BPN + 16 * ks + 8 * hi);
#pragma unroll
            for (int pt = 0; pt < 2; ++pt) acc[pt] = MFMA32(pf[pt][ks], cfk, acc[pt]); }
        const float el = __expf(tacs[hh * 128 + l]);
        float ss = 0.f;
#pragma unroll
        for (int pt = 0; pt < 2; ++pt)
#pragma unroll
            for (int i4 = 0; i4 < 4; ++i4) { const int p0 = pt * 32 + 8 * i4 + 4 * hi;
                const u32x2 xx = *(const LAS u32x2*)(Xs + l * XPN + hh * 64 + p0);
                const float z[4] = {__uint_as_float(zz[pt][i4].x << 16), __uint_as_float(zz[pt][i4].x & 0xffff0000u), __uint_as_float(zz[pt][i4].y << 16), __uint_as_float(zz[pt][i4].y & 0xffff0000u)};
                const float xv[4] = {__uint_as_float(xx.x << 16), __uint_as_float(xx.x & 0xffff0000u), __uint_as_float(xx.y << 16), __uint_as_float(xx.y & 0xffff0000u)};
#pragma unroll
                for (int e = 0; e < 4; ++e) { const float y = (yd[li][pt][4 * i4 + e] + el * acc[pt][4 * i4 + e] + Dk * xv[e]) * silu_f(z[e]); yd[li][pt][4 * i4 + e] = y; ss += y * y; } }
        ss += __shfl_xor(ss, 32);
        if (hi == 0) red[hh * 128 + l] = ss;
        __builtin_amdgcn_sched_barrier(0);
    }
    __syncthreads();
    LAS bf16* stg = (LAS bf16*)F.lds + w * (64 * 72);
#pragma unroll
    for (int li = 0; li < 2; ++li) {
        const int lt = (li == 0) ? pr : 3 - pr, l = lt * 32 + r32;
        const float rstd = rsqrtf(((red[l] + red[128 + l]) + (red[256 + l] + red[384 + l])) * (1.f / 256.f) + EPS);
#pragma unroll
        for (int pt = 0; pt < 2; ++pt)
#pragma unroll
            for (int i4 = 0; i4 < 4; ++i4) { const int cl = pt * 32 + 8 * i4 + 4 * hi; const f32x4 gg = *(const f32x4*)(F.ssm_g + h * 64 + cl);
                u32x2 wv; wv.x = pk2(yd[li][pt][4 * i4 + 0] * rstd * gg[0], yd[li][pt][4 * i4 + 1] * rstd * gg[1]); wv.y = pk2(yd[li][pt][4 * i4 + 2] * rstd * gg[2], yd[li][pt][4 * i4 + 3] * rstd * gg[3]);
                *(LAS u32x2*)(stg + (li * 32 + r32) * 72 + cl) = wv; }
    }
    asm volatile("s_waitcnt lgkmcnt(0)" ::: "memory");
#pragma unroll
    for (int it = 0; it < 8; ++it) { const int row = it * 8 + (lane >> 3), ch = lane & 7;
        const int lt = (row < 32) ? pr : 3 - pr, l = lt * 32 + (row & 31);
        const u32x4 v = *(const LAS u32x4*)(stg + row * 72 + ch * 8);
        *(u32x4*)(Y + (size_t)(row0 + l) * D + h * 64 + ch * 8) = v; }
    __syncthreads();
}

#define XB_TMO      128
#define XB_XCNT(j)  (256  + 64 * (j))
#define XB_XSUB(j)  (1280 + 64 * (j))
#define XB_XGEN(j)  (2304 + 64 * (j))
#define XB_TOP      3328
#define XB_TOPGEN   3392
#define XCD_BAR_WORDS 3456
#define XB_SPIN_CAP (1u << 18)
DI unsigned xb_ld(unsigned* p)              { return __hip_atomic_load(p, __ATOMIC_RELAXED, __HIP_MEMORY_SCOPE_AGENT); }
DI unsigned xb_add(unsigned* p, unsigned v) { return __hip_atomic_fetch_add(p, v, __ATOMIC_RELAXED, __HIP_MEMORY_SCOPE_AGENT); }
DI unsigned xb_xcc_id() { return (unsigned)__builtin_amdgcn_s_getreg((3 << 11) | 20) & 0xFu; }
#define XB_SPIN(cond, bar) do { unsigned _sp = 0; while (cond) { __builtin_amdgcn_s_sleep(1); \
    if ((++_sp & 255u) == 0u) { if (xb_ld(&(bar)[XB_TMO])) break; if (_sp > XB_SPIN_CAP) { atomicAdd(&(bar)[XB_TMO], 1u); break; } } } } while (0)
struct XcdBarrier { unsigned* bar; unsigned x; volatile LAS unsigned* st; };
DI XcdBarrier xcd_barrier_post(unsigned* bar, volatile LAS unsigned* st) {
    XcdBarrier b; b.bar = bar; b.x = xb_xcc_id(); b.st = st;
    if (threadIdx.x == 0) (void)xb_add(&bar[XB_XCNT(b.x)], 1u);
    return b;
}
DI void xcd_barrier_complete(unsigned* bar, unsigned x, unsigned& nloc, unsigned& nx) {
    const unsigned G = gridDim.x * gridDim.y * gridDim.z;
    unsigned sum, cnt, mine, sp = 0u;
    for (;;) {
        sum = 0u; cnt = 0u; mine = 0u;
#pragma unroll
        for (unsigned j = 0; j < 16; ++j) { const unsigned c = xb_ld(&bar[XB_XCNT(j)]); sum += c; cnt += (c > 0u) ? 1u : 0u; mine = (j == x) ? c : mine; }
        if (sum == G) break;
        __builtin_amdgcn_s_sleep(1);
        if ((++sp & 255u) == 0u) { if (xb_ld(&bar[XB_TMO])) break; if (sp > XB_SPIN_CAP) { atomicAdd(&bar[XB_TMO], 1u); break; } }
    }
    nloc = mine > 0u ? mine : 1u; nx = cnt > 0u ? cnt : 1u;
}
DI void xcd_barrier(const XcdBarrier& b) {
    asm volatile("s_waitcnt vmcnt(0)" ::: "memory");
    __syncthreads();
    if (threadIdx.x == 0) {
        unsigned* bar = b.bar;
        __builtin_amdgcn_s_waitcnt(0);
        unsigned nloc = b.st[0], nx = b.st[1];
        if (nloc == 0u) { xcd_barrier_complete(bar, b.x, nloc, nx); b.st[0] = nloc; b.st[1] = nx; }
        const unsigned old = xb_add(&bar[XB_XSUB(b.x)], 1u);
        const unsigned gen = old / nloc;
        if (old + 1u == (gen + 1u) * nloc) {
            __builtin_amdgcn_fence(__ATOMIC_RELEASE, "agent");
            asm volatile("s_waitcnt vmcnt(0)" ::: "memory");
            const unsigned og = xb_add(&bar[XB_TOP], 1u);
            const unsigned tg = og / nx;
            if (og + 1u == (tg + 1u) * nx) xb_add(&bar[XB_TOPGEN], 1u);
            else XB_SPIN(xb_ld(&bar[XB_TOPGEN]) == tg, bar);
            __builtin_amdgcn_fence(__ATOMIC_ACQUIRE, "agent");
            xb_add(&bar[XB_XGEN(b.x)], 1u);
            asm volatile("s_waitcnt vmcnt(0)" ::: "memory");
        } else {
            XB_SPIN(xb_ld(&bar[XB_XGEN(b.x)]) == gen, bar);
            __builtin_amdgcn_fence(__ATOMIC_ACQUIRE, "agent");
            asm volatile("s_waitcnt vmcnt(0)" ::: "memory");
        }
    }
    __syncthreads();
}

__global__ void __launch_bounds__(512, 2) mk_fwd(Args args) {
    extern __shared__ __attribute__((aligned(16))) unsigned char lds_raw[];
    Frame F;
    F.lds = (LAS unsigned char*)lds_raw;
    F.tid = threadIdx.x; F.lane = F.tid & 63; F.wave = __builtin_amdgcn_readfirstlane(F.tid >> 6); F.G = gridDim.x; F.blk = blockIdx.x;
    F.x = args.in[0]; F.mix_g = args.in[1]; F.w_in = args.in[2]; F.conv_w = args.in[3]; F.conv_b = args.in[4]; F.dt_bias = args.in[5]; F.A_log = args.in[6]; F.D_skip = args.in[7];
    F.ssm_g = args.in[8]; F.sinks = args.in[9]; F.att_g = args.in[10]; F.w_out = args.in[11]; F.mlp_g = args.in[12]; F.w_up = args.in[13]; F.w_down = args.in[14]; F.fin_g = args.in[15];
    F.out = args.out; F.ws = args.ws;
    bf16* XN = (bf16*)(F.ws + WS_XN); bf16* PROJ = (bf16*)(F.ws + WS_PROJ); bf16* Y = (bf16*)(F.ws + WS_Y); bf16* H = (bf16*)(F.ws + WS_H);
    float* SSQ1 = (float*)(F.ws + WS_SSQ1); float* SSQ2 = (float*)(F.ws + WS_SSQ2);
    if (F.tid < 16) ((LAS unsigned*)(F.lds + MISC_OFF))[F.tid] = 0u;
    __syncthreads();
    const XcdBarrier xbar = xcd_barrier_post((unsigned*)F.ws, (volatile LAS unsigned*)(F.lds + MISC_OFF));
    f32x16 yd[2][2];
#pragma unroll
    for (int a_ = 0; a_ < 2; ++a_)
#pragma unroll
        for (int b_ = 0; b_ < 2; ++b_)
#pragma unroll
            for (int i_ = 0; i_ < 16; ++i_) yd[a_][b_][i_] = 0.f;
    const int lo = args.ph_lo, hi = args.ph_hi;
    if (hi > 1000) cg::this_grid().sync();
#define IN(k) (lo <= (k) && (k) < hi)
#define SEAM(k) do { if (IN(k) && IN((k) + 1)) { xcd_barrier(xbar); } } while (0)
#define PH0() if (IN(0)) { p0_prologue(F); } SEAM(0);
#define PH1() if (IN(1)) { \
        pg8::Gemm g{XN, (const bf16*)(F.ws + WS_WIN), M, NPROJ, D}; pg8::StaticOrder S; S.init(M, NPROJ, F.G, F.blk); S.rebal = (F.G == 256) ? 1 : 0; \
        pg8::Epi<0> E{PROJ, NPROJ, nullptr, nullptr, nullptr, nullptr, nullptr}; \
        pg8::gemm_phase(F.lds, g, S, E); \
        dt_gemm(F); p0b_weights(F); } SEAM(1);
#define PH2() if (IN(2)) { if (F.blk < 256) { attn_item(F, F.blk); if (MK_PROBE_PHASE == 21) attn_item(F, F.blk); ssd_front(F, F.blk, yd); } } SEAM(2); \
    if (MK_PROBE_PHASE == 30) { for (int q_ = 0; q_ < 10; ++q_) xcd_barrier(xbar); } \
    if (IN(3)) { ssd_scan(F); } SEAM(3); \
    if (IN(4)) { if (F.blk < 256) ssd_back(F, F.blk, yd); } SEAM(4);
#define PH5() if (IN(5)) { \
        pg8::Gemm g{Y, (const bf16*)(F.ws + WS_WOUT), M, D, D}; pg8::StaticOrder S; S.init(M, D, F.G, F.blk); \
        pg8::Epi<1> E{XN, D, F.x, nullptr, SSQ1, nullptr, nullptr}; \
        pg8::gemm_phase(F.lds, g, S, E); } SEAM(5);
#define PH6() if (IN(6)) { \
        pg8::Gemm g{XN, (const bf16*)(F.ws + WS_WUP), M, FF, D}; pg8::StaticOrder S; S.init(M, FF, F.G, F.blk); \
        pg8::Epi<2> E{H, FF, nullptr, nullptr, nullptr, SSQ1, nullptr}; \
        pg8::gemm_phase(F.lds, g, S, E); } SEAM(6);
    PH0();
#if MK_PROBE_PHASE == 0
    PH0();
#endif
    PH1();
#if MK_PROBE_PHASE == 1
    PH1();
#endif
    PH2();
#if MK_PROBE_PHASE == 2
    PH2();
#endif
    PH5();
#if MK_PROBE_PHASE == 5
    PH5();
#endif
    PH6();
#if MK_PROBE_PHASE == 6
    PH6();
#endif
#define PH7() if (IN(7)) { \
        pg8::Gemm g{H, (const bf16*)(F.ws + WS_WDN), M, D, FF}; pg8::StaticOrder S; S.init(M, D, F.G, F.blk); \
        pg8::Epi<3> E{XN, D, F.fin_g, F.out, SSQ2, nullptr, (unsigned*)F.ws + 4096}; \
        pg8::gemm_phase(F.lds, g, S, E); }
    PH7();
#if MK_PROBE_PHASE == 7
    xcd_barrier(xbar);
    PH7();
#endif
}


extern "C" void kernel_launch(void* const* d_in, const int* in_sizes, int n_in, void* d_out, int out_size, void* d_ws, size_t ws_size, hipStream_t stream) {
    static int grid = 0;
    if (grid == 0) {
        int dev = 0, cus = 0, per_cu = 0;
        (void)hipGetDevice(&dev); (void)hipDeviceGetAttribute(&cus, hipDeviceAttributeMultiprocessorCount, dev);
        if (hipFuncSetAttribute((const void*)mk_fwd, hipFuncAttributeMaxDynamicSharedMemorySize, LDS_BYTES) != hipSuccess) { fprintf(stderr, "hipFuncSetAttribute failed\n"); }
        if (hipOccupancyMaxActiveBlocksPerMultiprocessor(&per_cu, (const void*)mk_fwd, 512, LDS_BYTES) != hipSuccess || per_cu < 1) per_cu = 1;
        (void)hipGetLastError();
        grid = cus * per_cu;
        if (grid <= 0) grid = 256;
        if (grid != 256) fprintf(stderr, "kernel_launch: grid %d != 256: the fused final norm needs one down-GEMM unit per workgroup\n", grid);
    }
    Args a{};
    for (int i = 0; i < 16; ++i) a.in[i] = (const float*)d_in[i];
    a.out = (float*)d_out; a.ws = (unsigned char*)d_ws;
    a.ph_lo = 0; a.ph_hi = 9;
    (void)hipMemsetAsync(d_ws, 0, 32768, stream);
    void* kargs[] = {&a};
    hipError_t e = hipLaunchCooperativeKernel((const void*)mk_fwd, dim3(grid), dim3(512), kargs, LDS_BYTES, stream);
    if (e != hipSuccess) fprintf(stderr, "cooperative launch failed: %s (grid %d)\n", hipGetErrorString(e), grid);
}
```

```cpp
#include <hip/hip_runtime.h>
#include <hip/hip_cooperative_groups.h>
#include <cstdio>
#include <cstdint>
namespace cg = cooperative_groups;

#ifndef MK_PROBE_PHASE
#define MK_PROBE_PHASE -1
#endif

#define DI __device__ __forceinline__
#define LAS __attribute__((address_space(3)))
typedef unsigned short bf16;
typedef short bf16x8 __attribute__((ext_vector_type(8)));
typedef float f32x4 __attribute__((ext_vector_type(4)));
typedef float f32x2 __attribute__((ext_vector_type(2)));
typedef unsigned u32x4 __attribute__((ext_vector_type(4)));
typedef unsigned u32x2 __attribute__((ext_vector_type(2)));
typedef float f32x16 __attribute__((ext_vector_type(16)));
typedef __bf16 bf16x2_t __attribute__((ext_vector_type(2)));

constexpr int M = 8192, D = 2048, SEQ = 2048, NBATCH = 4;
constexpr int NIN = 4368, NPROJ = 4352;
constexpr int PZ = 0, PXBC = 1024, PQ = 3072, PK = 4096, PV = 4224;
constexpr int DT_COL = 3072;
constexpr int NH = 16, HD = 64, NG = 4, NS = 128, DINNER = 1024, CONVD = 2048;
constexpr int FF = 8192;
constexpr float EPS = 1e-5f;

constexpr size_t MiB = 1u << 20;
constexpr size_t WS_WUP = 2 * MiB, WS_WDN = 34 * MiB, WS_XN = 66 * MiB;
constexpr size_t WS_SSQ1 = 98 * MiB, WS_SSQ2 = 98 * MiB + 256 * 1024, WS_DT = 98 * MiB + 512 * 1024;
constexpr size_t WS_H = 100 * MiB;
constexpr size_t WS_WIN = 100 * MiB, WS_WDT = 117 * MiB, WS_WOUT = 118 * MiB, WS_PROJ = 126 * MiB, WS_Y = 194 * MiB;
constexpr size_t WS_MISC = 228 * MiB;

constexpr int RING_BYTES = 131072, XLDS_OFF = RING_BYTES, LDS_BYTES = 149504 + 64, MISC_OFF = 149504;

DI float bf2f(bf16 v) { return __uint_as_float(((unsigned)v) << 16); }
DI unsigned f2bf(float f) { unsigned u = __float_as_uint(f); return (u + 0x7fffu + ((u >> 16) & 1u)) >> 16; }
DI unsigned pk2(float lo, float hi) { f32x2 v = {lo, hi}; bf16x2_t b = __builtin_convertvector(v, bf16x2_t); return __builtin_bit_cast(unsigned, b); }
DI float wave_sum(float v) {
#pragma unroll
    for (int o = 1; o < 64; o <<= 1) v += __shfl_xor(v, o);
    return v;
}
DI float silu_f(float x) { return x * __builtin_amdgcn_rcpf(1.f + __expf(-x)); }
DI float softplus_f(float x) { return x > 20.f ? x : log1pf(__expf(x)); }

namespace pg8 {
constexpr int BM = 256, BK = 64, HALF = 128, HTB = HALF * BK * 2, NXCD = 8, WGM = 8;
__host__ __device__ __forceinline__ int lds_byte(int r, int c) { const int st = (r >> 4) * 2 + (c >> 5), rr = r & 15, cc = c & 31, ob = rr * 64 + cc * 2; return st * 1024 + (ob ^ (((ob >> 9) & 1) << 5)); }
__host__ __device__ __forceinline__ void stage_rc(int b, int& R, int& C) { const int st = b / 1024, sb = b % 1024, swz = sb ^ (((sb >> 9) & 1) << 5); R = (st >> 1) * 16 + swz / 64; C = (st & 1) * 32 + (swz % 64) / 2; }
__host__ __device__ __forceinline__ int perm32(int rho) { const int n = rho >> 4, i = rho & 15; return 8 * (i >> 2) + 4 * n + (i & 3); }

struct Unit { int pm, pn; };
struct Gemm { const bf16* A; const bf16* Bt; int M, N, K; };
struct StaticOrder {
    int nM, nN, nwg, G, c;
    DI void init(int M_, int N_, int G_, int c_) { nM = M_ / BM; nN = N_ / BM; nwg = nM * nN; G = G_; c = c_; rebal = 0; }
    int rebal;
    DI bool next(int i, Unit& u) const {
        long L = (long)i * G + c;
        if (rebal) { if (i == 0) L = c; else if (i == 1) { if (c >= 144) return false; L = 256 + c; } else if (i == 2) { if (c >= 144) return false; L = 400 + c; } else return false; }
        if (L >= nwg) return false;
        int wgid = (int)L; { const int q = nwg / NXCD, r = nwg % NXCD, xcd = wgid % NXCD, off = wgid / NXCD; wgid = (xcd < r ? xcd * (q + 1) : r * (q + 1) + (xcd - r) * q) + off; }
        const int nig = WGM * nN, gid = wgid / nig, fm = gid * WGM, gsz = (nM - fm) < WGM ? (nM - fm) : WGM;
        u.pm = fm + ((wgid % nig) % gsz); u.pn = (wgid % nig) / gsz; return true;
    }
};

template <class Epi>
DI void gemm_phase(LAS unsigned char* lds, const Gemm g, const StaticOrder& S, const Epi& E) {
    const int tid = threadIdx.x, wid = __builtin_amdgcn_readfirstlane(tid >> 6), lane = tid & 63, wr = wid >> 2, wc = wid & 3, fr = lane & 15, fq = lane >> 4;
    const int K = g.K, nt = K / BK;
    unsigned voffA[2], voffB[2];
#pragma unroll
    for (int i = 0; i < 2; ++i) { int R, C; stage_rc(tid * 16 + i * 8192, R, C); const int Rb = (R & ~31) + perm32(R & 31);
        voffA[i] = (unsigned)(R * K + C) * 2u; voffB[i] = (unsigned)(Rb * K + C) * 2u; }
    const size_t kstep = (size_t)(BK * 2);
    const size_t hstep = (size_t)HALF * K * 2;
    const size_t tstep = 2 * hstep;
    const unsigned ldsw = (unsigned)wid * 1024u;
    const int aoff = lds_byte(wr * 64 + fr, fq * 8), boff = lds_byte(wc * 32 + fr, fq * 8);
#define PG8_SA(b, h) (((b) * 2 + (h)) * HTB)
#define PG8_SB(b, h) ((4 + (b) * 2 + (h)) * HTB)
#define PG8_STAGE(bufoff, gbase, voff) do { _Pragma("unroll") for (int _i = 0; _i < 2; ++_i) \
        __builtin_amdgcn_global_load_lds((const unsigned*)((const char*)(gbase) + (voff)[_i]), (LAS unsigned*)(lds + (bufoff) + ldsw + _i * 8192), 16, 0, 0); } while (0)
#define PG8_LDA(dst, b, h) do { _Pragma("unroll") for (int m = 0; m < 4; ++m) _Pragma("unroll") for (int k = 0; k < 2; ++k) dst[m][k] = *(const LAS bf16x8*)(lds + PG8_SA(b, h) + aoff + m * 2048 + k * 1024); } while (0)
#define PG8_LDB(dst, b, h) do { _Pragma("unroll") for (int n = 0; n < 2; ++n) _Pragma("unroll") for (int k = 0; k < 2; ++k) dst[n][k] = *(const LAS bf16x8*)(lds + PG8_SB(b, h) + boff + n * 2048 + k * 1024); } while (0)
#define PG8_MMA(ai, bj, At, Bt) do { __builtin_amdgcn_s_setprio(1); _Pragma("unroll") for (int m = 0; m < 4; ++m) _Pragma("unroll") for (int n = 0; n < 2; ++n) _Pragma("unroll") for (int k = 0; k < 2; ++k) \
        acc[ai][bj][m][n] = __builtin_amdgcn_mfma_f32_16x16x32_bf16(Bt[n][k], At[m][k], acc[ai][bj][m][n], 0, 0, 0); __builtin_amdgcn_s_setprio(0); } while (0)
#define PG8_WAIT_V(n) asm volatile("s_waitcnt vmcnt(" #n ")" ::: "memory")
#define PG8_WAIT_L(n) asm volatile("s_waitcnt lgkmcnt(" #n ")" ::: "memory")
#define PG8_BAR __builtin_amdgcn_s_barrier()
#define PG8_SCHED __builtin_amdgcn_sched_barrier(0)
    Unit cur, nxt; int ui = 0;
    if (!S.next(0, cur)) return;
    f32x4 acc[2][2][4][2];
#pragma unroll
    for (int a = 0; a < 2; ++a)
#pragma unroll
        for (int b = 0; b < 2; ++b)
#pragma unroll
            for (int m = 0; m < 4; ++m)
#pragma unroll
                for (int n = 0; n < 2; ++n) acc[a][b][m][n] = (f32x4){0.f, 0.f, 0.f, 0.f};
    bf16x8 At[4][2], B0[2][2], B1[2][2];
    const char* cA = (const char*)g.A + (size_t)cur.pm * tstep; const char* cB = (const char*)g.Bt + (size_t)cur.pn * tstep;
    PG8_STAGE(PG8_SB(0, 0), cB, voffB); PG8_STAGE(PG8_SB(0, 1), cB + hstep, voffB); PG8_STAGE(PG8_SA(0, 0), cA, voffA); PG8_STAGE(PG8_SA(0, 1), cA + hstep, voffA);
    if (wr == 1) PG8_BAR;
    PG8_WAIT_V(2); PG8_BAR;
    PG8_STAGE(PG8_SB(1, 0), cB + kstep, voffB); PG8_STAGE(PG8_SA(1, 0), cA + kstep, voffA); PG8_STAGE(PG8_SB(1, 1), cB + hstep + kstep, voffB);
    PG8_WAIT_V(6); PG8_BAR;
    for (;;) {
        const bool has_next = S.next(ui + 1, nxt);
        const char* nA = has_next ? (const char*)g.A + (size_t)nxt.pm * tstep : cA; const char* nB = has_next ? (const char*)g.Bt + (size_t)nxt.pn * tstep : cB;
        for (int t = 0; t < nt; t += 2) {
            const bool last = (t == nt - 2);
            const char* a1 = cA + (size_t)(t + 1) * kstep;
            const char* a2 = last ? nA : cA + (size_t)(t + 2) * kstep; const char* b2 = last ? nB : cB + (size_t)(t + 2) * kstep;
            const char* a3 = a2 + kstep; const char* b3 = b2 + kstep;
            PG8_LDB(B0, 0, 0); PG8_LDB(B1, 0, 1); PG8_SCHED; PG8_LDA(At, 0, 0); PG8_STAGE(PG8_SA(1, 1), a1 + hstep, voffA);
            PG8_WAIT_V(8); PG8_WAIT_L(0); PG8_BAR; PG8_MMA(0, 0, At, B0); PG8_MMA(0, 1, At, B1); PG8_BAR; PG8_SCHED;
            PG8_LDA(At, 0, 1); PG8_STAGE(PG8_SB(0, 0), b2, voffB); PG8_STAGE(PG8_SB(0, 1), b2 + hstep, voffB); PG8_STAGE(PG8_SA(0, 0), a2, voffA);
            PG8_WAIT_V(8); PG8_WAIT_L(0); PG8_BAR; PG8_MMA(1, 0, At, B0); PG8_MMA(1, 1, At, B1); PG8_BAR; PG8_SCHED;
            PG8_LDB(B0, 1, 0); PG8_LDB(B1, 1, 1); PG8_SCHED; PG8_LDA(At, 1, 0); PG8_STAGE(PG8_SA(0, 1), a2 + hstep, voffA);
            PG8_WAIT_V(8); PG8_WAIT_L(0); PG8_BAR; PG8_MMA(0, 0, At, B0); PG8_MMA(0, 1, At, B1); PG8_BAR; PG8_SCHED;
            PG8_LDA(At, 1, 1); PG8_STAGE(PG8_SB(1, 0), b3, voffB); PG8_STAGE(PG8_SB(1, 1), b3 + hstep, voffB); PG8_STAGE(PG8_SA(1, 0), a3, voffA);
            PG8_WAIT_V(8); PG8_WAIT_L(0); PG8_BAR; PG8_MMA(1, 0, At, B0); PG8_MMA(1, 1, At, B1); PG8_BAR; PG8_SCHED;
        }
        if (wr == 0) PG8_BAR;
        E(acc, cur, wr, wc, fr, fq, lds + XLDS_OFF);
        if (!has_next) break;
#pragma unroll
        for (int a = 0; a < 2; ++a)
#pragma unroll
            for (int b = 0; b < 2; ++b)
#pragma unroll
                for (int m = 0; m < 4; ++m)
#pragma unroll
                    for (int n = 0; n < 2; ++n) acc[a][b][m][n] = (f32x4){0.f, 0.f, 0.f, 0.f};
        cur = nxt; cA = nA; cB = nB; ++ui;
        if (wr == 1) PG8_BAR;
    }
    PG8_WAIT_V(0);
    PG8_BAR;
#undef PG8_SA
#undef PG8_SB
#undef PG8_STAGE
#undef PG8_LDA
#undef PG8_LDB
#undef PG8_MMA
#undef PG8_WAIT_V
#undef PG8_WAIT_L
#undef PG8_BAR
#undef PG8_SCHED
}

template <int MODE> struct Epi {
    bf16* O; int ldc; const float* base; float* outf; float* ssq; const float* ssq_in; unsigned* cnt;
    DI void operator()(f32x4 (&acc)[2][2][4][2], const Unit& u, int wr, int wc, int fr, int fq, LAS unsigned char* xl) const {
        const int row0 = u.pm * BM + wr * 64 + fr, col0 = u.pn * BM + wc * 32 + 8 * fq;
        if (MODE == 0) {
#pragma unroll
            for (int ai = 0; ai < 2; ++ai)
#pragma unroll
                for (int m = 0; m < 4; ++m) { bf16* rowp = O + (size_t)(row0 + ai * HALF + m * 16) * ldc + col0;
#pragma unroll
                    for (int bj = 0; bj < 2; ++bj) { const f32x4 v0 = acc[ai][bj][m][0], v1 = acc[ai][bj][m][1];
                        u32x4 w; w.x = pk2(v0[0], v0[1]); w.y = pk2(v0[2], v0[3]); w.z = pk2(v1[0], v1[1]); w.w = pk2(v1[2], v1[3]);
                        *(u32x4*)(rowp + bj * HALF) = w; } }
        } else if (MODE == 1) {
            LAS float* P = (LAS float*)xl;
#pragma unroll
            for (int ai = 0; ai < 2; ++ai)
#pragma unroll
                for (int m = 0; m < 4; ++m) { const int rl = ai * HALF + wr * 64 + m * 16 + fr; const size_t off = (size_t)(u.pm * BM + rl) * ldc + col0; float ss = 0.f;
#pragma unroll
                    for (int bj = 0; bj < 2; ++bj) {
                        const f32x4 x0 = *(const f32x4*)(base + off + bj * HALF), x1 = *(const f32x4*)(base + off + bj * HALF + 4);
                        const f32x4 v0 = acc[ai][bj][m][0] + x0, v1 = acc[ai][bj][m][1] + x1;
                        if (outf) { *(f32x4*)(outf + off + bj * HALF) = v0; *(f32x4*)(outf + off + bj * HALF + 4) = v1; }
                        if (O) { u32x4 w; w.x = pk2(v0[0], v0[1]); w.y = pk2(v0[2], v0[3]); w.z = pk2(v1[0], v1[1]); w.w = pk2(v1[2], v1[3]); *(u32x4*)(O + off + bj * HALF) = w; }
                        ss += (v0[0] * v0[0] + v0[1] * v0[1]) + (v0[2] * v0[2] + v0[3] * v0[3]) + (v1[0] * v1[0] + v1[1] * v1[1]) + (v1[2] * v1[2] + v1[3] * v1[3]);
                    }
                    ss += __shfl_xor(ss, 16); ss += __shfl_xor(ss, 32);
                    if (fq == 0) P[rl * 4 + wc] = ss; }
            asm volatile("s_waitcnt lgkmcnt(0)" ::: "memory"); __builtin_amdgcn_s_barrier(); asm volatile("" ::: "memory");
            if (threadIdx.x < 256) { const int t = threadIdx.x; const float s = (P[t * 4 + 0] + P[t * 4 + 1]) + (P[t * 4 + 2] + P[t * 4 + 3]); ssq[(size_t)(u.pm * BM + t) * 8 + u.pn] = s; }
            asm volatile("s_waitcnt lgkmcnt(0)" ::: "memory"); __builtin_amdgcn_s_barrier(); asm volatile("" ::: "memory");
        } else if (MODE == 3) {
            LAS float* P = (LAS float*)xl; LAS float* R = (LAS float*)(xl + 4096);
#pragma unroll
            for (int ai = 0; ai < 2; ++ai)
#pragma unroll
                for (int m = 0; m < 4; ++m) { const int rl = ai * HALF + wr * 64 + m * 16 + fr; const size_t off = (size_t)(u.pm * BM + rl) * ldc + col0; float ss = 0.f;
#pragma unroll
                    for (int bj = 0; bj < 2; ++bj) { const u32x4 xb = *(const u32x4*)(O + off + bj * HALF);
                        f32x4 v0 = acc[ai][bj][m][0], v1 = acc[ai][bj][m][1];
                        v0[0] += __uint_as_float(xb.x << 16); v0[1] += __uint_as_float(xb.x & 0xffff0000u); v0[2] += __uint_as_float(xb.y << 16); v0[3] += __uint_as_float(xb.y & 0xffff0000u);
                        v1[0] += __uint_as_float(xb.z << 16); v1[1] += __uint_as_float(xb.z & 0xffff0000u); v1[2] += __uint_as_float(xb.w << 16); v1[3] += __uint_as_float(xb.w & 0xffff0000u);
                        acc[ai][bj][m][0] = v0; acc[ai][bj][m][1] = v1;
                        ss += (v0[0] * v0[0] + v0[1] * v0[1]) + (v0[2] * v0[2] + v0[3] * v0[3]) + (v1[0] * v1[0] + v1[1] * v1[1]) + (v1[2] * v1[2] + v1[3] * v1[3]); }
                    ss += __shfl_xor(ss, 16); ss += __shfl_xor(ss, 32);
                    if (fq == 0) P[rl * 4 + wc] = ss; }
            asm volatile("s_waitcnt lgkmcnt(0)" ::: "memory"); __builtin_amdgcn_s_barrier(); asm volatile("" ::: "memory");
            const int t = threadIdx.x;
            if (t < 256) { const float sp = (P[t * 4 + 0] + P[t * 4 + 1]) + (P[t * 4 + 2] + P[t * 4 + 3]);
                __hip_atomic_store(ssq + (size_t)(u.pm * BM + t) * 8 + u.pn, sp, __ATOMIC_RELAXED, __HIP_MEMORY_SCOPE_AGENT); }
            asm volatile("s_waitcnt vmcnt(0)" ::: "memory"); __builtin_amdgcn_s_barrier(); asm volatile("" ::: "memory");
            if (t == 0) {
                __hip_atomic_fetch_add(cnt + 64 * u.pm, 1u, __ATOMIC_RELAXED, __HIP_MEMORY_SCOPE_AGENT);
                unsigned sp_ = 0;
                while (__hip_atomic_load(cnt + 64 * u.pm, __ATOMIC_RELAXED, __HIP_MEMORY_SCOPE_AGENT) < 8u) { __builtin_amdgcn_s_sleep(1); if (++sp_ > (1u << 22)) break; }
                __builtin_amdgcn_fence(__ATOMIC_ACQUIRE, "agent");
            }
            asm volatile("s_waitcnt vmcnt(0) lgkmcnt(0)" ::: "memory"); __builtin_amdgcn_s_barrier(); asm volatile("" ::: "memory");
            if (t < 256) { float tot = 0.f;
#pragma unroll
                for (int j = 0; j < 8; ++j) tot += __hip_atomic_load(ssq + (size_t)(u.pm * BM + t) * 8 + j, __ATOMIC_RELAXED, __HIP_MEMORY_SCOPE_AGENT);
                R[t] = rsqrtf(tot * (1.f / 2048.f) + EPS); }
            asm volatile("s_waitcnt vmcnt(0) lgkmcnt(0)" ::: "memory"); __builtin_amdgcn_s_barrier(); asm volatile("" ::: "memory");
            f32x4 gv[2][2];
#pragma unroll
            for (int bj = 0; bj < 2; ++bj) { gv[bj][0] = *(const f32x4*)(base + col0 + bj * HALF); gv[bj][1] = *(const f32x4*)(base + col0 + bj * HALF + 4); }
#pragma unroll
            for (int ai = 0; ai < 2; ++ai)
#pragma unroll
                for (int m = 0; m < 4; ++m) { const int rl = ai * HALF + wr * 64 + m * 16 + fr; const size_t off = (size_t)(u.pm * BM + rl) * ldc + col0; const float rstd = R[rl];
#pragma unroll
                    for (int bj = 0; bj < 2; ++bj) { *(f32x4*)(outf + off + bj * HALF) = acc[ai][bj][m][0] * rstd * gv[bj][0]; *(f32x4*)(outf + off + bj * HALF + 4) = acc[ai][bj][m][1] * rstd * gv[bj][1]; } }
        } else {
#pragma unroll
            for (int ai = 0; ai < 2; ++ai)
#pragma unroll
                for (int m = 0; m < 4; ++m) { const int row = row0 + ai * HALF + m * 16;
                    const f32x4 s0 = *(const f32x4*)(ssq_in + (size_t)row * 8), s1 = *(const f32x4*)(ssq_in + (size_t)row * 8 + 4);
                    const float rstd = rsqrtf(((s0[0] + s0[1]) + (s0[2] + s0[3]) + (s1[0] + s1[1]) + (s1[2] + s1[3])) * (1.f / 2048.f) + EPS);
                    bf16* rowp = O + (size_t)row * ldc + col0;
#pragma unroll
                    for (int bj = 0; bj < 2; ++bj) { f32x4 v0 = acc[ai][bj][m][0] * rstd, v1 = acc[ai][bj][m][1] * rstd;
#pragma unroll
                        for (int e = 0; e < 4; ++e) { const float a = fmaxf(v0[e], 0.f), b = fmaxf(v1[e], 0.f); v0[e] = a * a; v1[e] = b * b; }
                        u32x4 w; w.x = pk2(v0[0], v0[1]); w.y = pk2(v0[2], v0[3]); w.z = pk2(v1[0], v1[1]); w.w = pk2(v1[2], v1[3]);
                        *(u32x4*)(rowp + bj * HALF) = w; } }
        }
    }
};
}

struct Args { const float* in[16]; float* out; unsigned char* ws; int ph_lo, ph_hi; };

struct Frame {
    LAS unsigned char* lds; int tid, lane, wave, G, blk;
    const float *x, *mix_g, *w_in, *conv_w, *conv_b, *dt_bias, *A_log, *D_skip, *ssm_g, *sinks, *att_g, *w_out, *mlp_g, *w_up, *w_down, *fin_g;
    float* out; unsigned char* ws;
};

DI void p0_transpose_item(const float* W, int ldw, int src_col0, bf16* WT, int K, int dst_row0, const float* gs, LAS float* scr, int kb, int nb, int lane) {
    const int k0 = 64 * kb, n0 = 32 * nb;
    float v[32];
#pragma unroll
    for (int i = 0; i < 32; ++i) { const int kk = 2 * i + (lane >> 5); v[i] = W[(size_t)(k0 + kk) * ldw + src_col0 + n0 + (lane & 31)]; }
    if (gs) {
#pragma unroll
        for (int i = 0; i < 32; ++i) v[i] *= gs[k0 + 2 * i + (lane >> 5)]; }
#pragma unroll
    for (int i = 0; i < 32; ++i) scr[(2 * i + (lane >> 5)) * 33 + (lane & 31)] = v[i];
    asm volatile("s_waitcnt lgkmcnt(0)" ::: "memory");
    const int c = lane & 7;
#pragma unroll
    for (int j = 0; j < 4; ++j) { const int n = (lane >> 3) + 8 * j; const LAS float* s = scr + (8 * c) * 33 + n;
        u32x4 o; o.x = pk2(s[0 * 33], s[1 * 33]); o.y = pk2(s[2 * 33], s[3 * 33]); o.z = pk2(s[4 * 33], s[5 * 33]); o.w = pk2(s[6 * 33], s[7 * 33]);
        *(u32x4*)(WT + (size_t)(dst_row0 + n0 + n) * K + k0 + 8 * c) = o; }
    asm volatile("s_waitcnt lgkmcnt(0)" ::: "memory");
}
DI void p0_prologue(Frame& F) {
    LAS float* scr = (LAS float*)(F.lds + F.wave * 16384);
    const int gw = F.blk * 8 + F.wave, NGW = F.G * 8;
    bf16* Win_t = (bf16*)(F.ws + WS_WIN);
    bf16* Wdt_t = (bf16*)(F.ws + WS_WDT); bf16* XN = (bf16*)(F.ws + WS_XN);
    constexpr int I_A = 32 * 96, I_B = 32 * 40;
    constexpr int NITEMS = I_A + I_B;
    for (int it = gw; it < NITEMS; it += NGW) {
        int r = it;
        if (r < I_A) { p0_transpose_item(F.w_in, NIN, 0, Win_t, D, 0, nullptr, scr, r / 96, r % 96, F.lane); continue; } r -= I_A;
        p0_transpose_item(F.w_in, NIN, DT_COL + 16, Win_t, D, DT_COL, nullptr, scr, r / 40, r % 40, F.lane);
    }
    for (int i = F.blk * 512 + F.tid; i < 16 * D; i += F.G * 512) { const int j = i / D, k = i % D; Wdt_t[i] = (bf16)f2bf(F.w_in[(size_t)k * NIN + DT_COL + j]); }
    {
        const f32x4* gr = (const f32x4*)F.mix_g + F.lane;
        f32x4 v[8], nv[8];
        int m = gw;
        if (m < M) {
            const f32x4* xr = (const f32x4*)(F.x + (size_t)m * D) + F.lane;
#pragma unroll
            for (int j = 0; j < 8; ++j) v[j] = xr[64 * j];
        }
        for (; m < M; m += NGW) {
            const int mn = m + NGW;
            if (mn < M) { const f32x4* xr = (const f32x4*)(F.x + (size_t)mn * D) + F.lane;
#pragma unroll
                for (int j = 0; j < 8; ++j) nv[j] = xr[64 * j]; }
            float s = 0.f;
#pragma unroll
            for (int j = 0; j < 8; ++j) s += (v[j][0] * v[j][0] + v[j][1] * v[j][1]) + (v[j][2] * v[j][2] + v[j][3] * v[j][3]);
            const float rstd = rsqrtf(wave_sum(s) * (1.f / D) + EPS);
            u32x2* o8 = (u32x2*)(XN + (size_t)m * D) + F.lane;
#pragma unroll
            for (int j = 0; j < 8; ++j) { const f32x4 g = gr[64 * j]; u32x2 w; w.x = pk2(v[j][0] * rstd * g[0], v[j][1] * rstd * g[1]); w.y = pk2(v[j][2] * rstd * g[2], v[j][3] * rstd * g[3]); o8[64 * j] = w; }
#pragma unroll
            for (int j = 0; j < 8; ++j) v[j] = nv[j];
        }
    }
}

struct TrItem { const float* W; bf16* WT; const float* gs; int ldw, K, k0, n0; };
DI TrItem p0b_decode(const Frame& F, int r) {
    constexpr int I_O = 32 * 64, I_U = 32 * 256;
    TrItem t;
    if (r < I_O) { t.W = F.w_out; t.WT = (bf16*)(F.ws + WS_WOUT); t.gs = nullptr; t.ldw = D; t.K = D; t.k0 = 64 * (r / 64); t.n0 = 32 * (r % 64); return t; } r -= I_O;
    if (r < I_U) { t.W = F.w_up; t.WT = (bf16*)(F.ws + WS_WUP); t.gs = F.mlp_g; t.ldw = FF; t.K = D; t.k0 = 64 * (r / 256); t.n0 = 32 * (r % 256); return t; } r -= I_U;
    t.W = F.w_down; t.WT = (bf16*)(F.ws + WS_WDN); t.gs = nullptr; t.ldw = D; t.K = FF; t.k0 = 64 * (r / 64); t.n0 = 32 * (r % 64); return t;
}
DI void p0b_load(const TrItem& t, int lane, float (&v)[32]) {
    const float* p = t.W + (size_t)(t.k0 + (lane >> 5)) * t.ldw + t.n0 + (lane & 31);
#pragma unroll
    for (int i = 0; i < 32; ++i) v[i] = p[(size_t)(2 * i) * t.ldw];
}
DI void p0b_weights(Frame& F) {
    LAS float* scr = (LAS float*)(F.lds + F.wave * 16384);
    constexpr int NIT_ALL = 32 * 64 + 32 * 256 + 128 * 64, NIT_EARLY = 9216;
    const int lane = F.lane;
    int it, stride, NIT;
    if (F.G == 256) {
        if (F.blk < 144) return;
        it = (F.blk - 144) * 8 + F.wave; stride = 896; NIT = NIT_ALL;
    } else {
        const int nb = (F.G > 32) ? F.G - 32 : F.G, vb = (F.G > 32) ? F.blk - 32 : F.blk;
        if (vb < 0) return;
        it = vb * 8 + F.wave; stride = nb * 8; NIT = NIT_ALL;
    }
    if (it >= NIT) return;
    TrItem cur = p0b_decode(F, it);
    float v[32]; p0b_load(cur, lane, v);
    for (;;) {
        const int nx = it + stride; const bool more = nx < NIT;
        TrItem nxt = cur; float w[32];
        if (more) { nxt = p0b_decode(F, nx); p0b_load(nxt, lane, w); }
#pragma unroll
        for (int i = 0; i < 32; ++i) scr[(2 * i + (lane >> 5)) * 33 + (lane & 31)] = v[i];
        asm volatile("s_waitcnt lgkmcnt(0)" ::: "memory");
        const int c = lane & 7;
        float g8[8];
#pragma unroll
        for (int e = 0; e < 8; ++e) g8[e] = 1.f;
        if (cur.gs) { const f32x4 g0 = *(const f32x4*)(cur.gs + cur.k0 + 8 * c), g1 = *(const f32x4*)(cur.gs + cur.k0 + 8 * c + 4);
#pragma unroll
            for (int e = 0; e < 4; ++e) { g8[e] = g0[e]; g8[4 + e] = g1[e]; } }
#pragma unroll
        for (int j = 0; j < 4; ++j) { const int n = (lane >> 3) + 8 * j; const LAS float* sp = scr + (8 * c) * 33 + n;
            u32x4 o; o.x = pk2(sp[0 * 33] * g8[0], sp[1 * 33] * g8[1]); o.y = pk2(sp[2 * 33] * g8[2], sp[3 * 33] * g8[3]); o.z = pk2(sp[4 * 33] * g8[4], sp[5 * 33] * g8[5]); o.w = pk2(sp[6 * 33] * g8[6], sp[7 * 33] * g8[7]);
            *(u32x4*)(cur.WT + (size_t)(cur.n0 + n) * cur.K + cur.k0 + 8 * c) = o; }
        asm volatile("s_waitcnt lgkmcnt(0)" ::: "memory");
        if (!more) break;
        it = nx; cur = nxt;
#pragma unroll
        for (int i = 0; i < 32; ++i) v[i] = w[i];
    }
}

DI void dt_gemm(Frame& F) {
    const bf16* XN = (const bf16*)(F.ws + WS_XN); const bf16* Wdt_t = (const bf16*)(F.ws + WS_WDT); float* DT = (float*)(F.ws + WS_DT);
    const int skip = (F.G == 256) ? 144 : ((F.G > 32) ? 32 : 0);
    const int nb = F.G - skip, vb = F.blk - skip;
    if (vb < 0) return;
    LAS f32x4* part = (LAS f32x4*)F.lds;
    const int fr = F.lane & 15, fq = F.lane >> 4, rgl = F.wave >> 2, kp = F.wave & 3;
    for (int pair = vb; pair < M / 32; pair += nb) {
        const int rg = pair * 2 + rgl;
        const bf16* ap = XN + (size_t)(rg * 16 + fr) * D + kp * 512 + fq * 8; const bf16* bp = Wdt_t + (size_t)fr * D + kp * 512 + fq * 8;
        bf16x8 av[16], bv[16];
#pragma unroll
        for (int k = 0; k < 16; ++k) { av[k] = *(const bf16x8*)(ap + 32 * k); bv[k] = *(const bf16x8*)(bp + 32 * k); }
        f32x4 acc = {0.f, 0.f, 0.f, 0.f};
#pragma unroll
        for (int k = 0; k < 16; ++k) acc = __builtin_amdgcn_mfma_f32_16x16x32_bf16(av[k], bv[k], acc, 0, 0, 0);
        part[F.wave * 64 + F.lane] = acc;
        __syncthreads();
        if (kp == 0) { const f32x4 t = (part[(rgl * 4 + 0) * 64 + F.lane] + part[(rgl * 4 + 1) * 64 + F.lane]) + (part[(rgl * 4 + 2) * 64 + F.lane] + part[(rgl * 4 + 3) * 64 + F.lane]);
#pragma unroll
            for (int jj = 0; jj < 4; ++jj) DT[(size_t)(rg * 16 + fq * 4 + jj) * 16 + fr] = t[jj]; }
        __syncthreads();
    }
}


#define MFMA32(a, b, c) __builtin_amdgcn_mfma_f32_32x32x16_bf16((a), (b), (c), 0, 0, 0)
DI int crow(int i, int hi) { return (i & 3) + 8 * (i >> 2) + 4 * hi; }
DI bf16x8 pack8(const f32x16& x, int s) {
    u32x4 p; p.x = pk2(x[8 * s + 0], x[8 * s + 1]); p.y = pk2(x[8 * s + 2], x[8 * s + 3]); p.z = pk2(x[8 * s + 4], x[8 * s + 5]); p.w = pk2(x[8 * s + 6], x[8 * s + 7]);
    return __builtin_bit_cast(bf16x8, p);
}
typedef short v4i16_t __attribute__((ext_vector_type(4)));
DI v4i16_t tr4(const LAS bf16* p) { return __builtin_amdgcn_ds_read_tr16_b64_v4i16((LAS v4i16_t*)p); }
DI bf16x8 tr_frag(const LAS bf16* T, int P, int Ra, int Rb, int cbase, int lane) {
    const int q = (lane & 15) >> 2, p4 = lane & 3, blk = (lane >> 4) & 1, co = cbase + 16 * blk + 4 * p4;
    const v4i16_t lo = tr4(T + (Ra + q) * P + co), hi = tr4(T + (Rb + q) * P + co);
    return (bf16x8){lo[0], lo[1], lo[2], lo[3], hi[0], hi[1], hi[2], hi[3]};
}
constexpr int KS_PITCH = 72;
DI void attn_item(Frame& F, int item) {
    const bf16* proj = (const bf16*)(F.ws + WS_PROJ); bf16* Y = (bf16*)(F.ws + WS_Y);
    LAS bf16* Vs = (LAS bf16*)F.lds;
    LAS bf16* Ks = (LAS bf16*)(F.lds + 2 * 160 * KS_PITCH * 2);
    LAS float* red = (LAS float*)(F.lds + 4 * 160 * KS_PITCH * 2);
    const int b = item >> 6, l0 = (item & 63) * 32, t0 = b * SEQ + l0, tmin = b * SEQ;
    const int lane = F.lane, r32 = lane & 31, hi = lane >> 5, w = F.wave;
    bf16x8 qf[2][4];
#pragma unroll
    for (int hh = 0; hh < 2; ++hh)
#pragma unroll
        for (int s = 0; s < 4; ++s) qf[hh][s] = *(const bf16x8*)(proj + (size_t)(t0 + r32) * NPROJ + PQ + (2 * w + hh) * 64 + 16 * s + 8 * hi);
#pragma unroll
    for (int j = 0; j < 10; ++j) { const int rr = (j * 8 + w) * 8 + (lane >> 3), ch = lane & 7;
        const int tsel = rr / 320, rem = rr % 320, kvh = rem / 160, kk = rem % 160;
        int row = t0 - 128 + kk; if (row < tmin) row = tmin;
        const bf16x8 v = *(const bf16x8*)(proj + (size_t)row * NPROJ + (tsel ? PV : PK) + kvh * 64 + ch * 8);
        *(LAS bf16x8*)((tsel ? Vs : Ks) + (kvh * 160 + kk) * KS_PITCH + ch * 8) = v; }
    __syncthreads();
    const int kv = w >> 2;
    f32x16 o[2][2]; float ssq = 0.f;
#pragma unroll
    for (int hh = 0; hh < 2; ++hh) {
        const int hq = 2 * w + hh;
        f32x16 S[5];
#pragma unroll
        for (int tile = 0; tile < 5; ++tile) {
            const LAS bf16* kp = Ks + (kv * 160 + tile * 32 + r32) * KS_PITCH + 8 * hi;
            f32x16 a;
#pragma unroll
            for (int i = 0; i < 16; ++i) a[i] = 0.f;
#pragma unroll
            for (int s = 0; s < 4; ++s) { const bf16x8 kf = *(const LAS bf16x8*)(kp + 16 * s); a = MFMA32(kf, qf[hh][s], a); }
            S[tile] = a;
        }
        __builtin_amdgcn_sched_barrier(0);
        constexpr float SC2 = 0.125f * 1.4426950408889634f;
        const float sink = F.sinks[hq] * 1.4426950408889634f; float mx = sink;
#pragma unroll
        for (int tile = 0; tile < 5; ++tile) { const bool tv = (l0 + 32 * tile >= 128);
#pragma unroll
            for (int i = 0; i < 16; ++i) { bool valid;
                if (tile == 0) valid = tv && (crow(i, hi) > r32); else if (tile == 4) valid = (crow(i, hi) <= r32); else valid = tv;
                const float sv = valid ? S[tile][i] * SC2 : -INFINITY; S[tile][i] = sv; mx = fmaxf(mx, sv); } }
        mx = fmaxf(mx, __shfl_xor(mx, 32));
        float den = 0.f;
#pragma unroll
        for (int tile = 0; tile < 5; ++tile)
#pragma unroll
            for (int i = 0; i < 16; ++i) { const float p = __builtin_amdgcn_exp2f(S[tile][i] - mx); S[tile][i] = p; den += p; }
        den += __shfl_xor(den, 32); den += __builtin_amdgcn_exp2f(sink - mx);
        const float inv = 1.f / den;
        __builtin_amdgcn_sched_barrier(0);
        f32x16 oT[2];
#pragma unroll
        for (int dh = 0; dh < 2; ++dh)
#pragma unroll
            for (int i = 0; i < 16; ++i) oT[dh][i] = 0.f;
#pragma unroll
        for (int tile = 0; tile < 5; ++tile)
#pragma unroll
            for (int s2 = 0; s2 < 2; ++s2) { const bf16x8 pf = pack8(S[tile], s2);
#pragma unroll
                for (int dh = 0; dh < 2; ++dh) { const bf16x8 va = tr_frag(Vs + kv * 160 * KS_PITCH, KS_PITCH, tile * 32 + 16 * s2 + 4 * hi, tile * 32 + 16 * s2 + 4 * hi + 8, dh * 32, lane); oT[dh] = MFMA32(va, pf, oT[dh]); } }
#pragma unroll
        for (int dh = 0; dh < 2; ++dh)
#pragma unroll
            for (int i = 0; i < 16; ++i) { const float v = oT[dh][i] * inv; o[hh][dh][i] = v; ssq += v * v; }
        __builtin_amdgcn_sched_barrier(0);
    }
    ssq += __shfl_xor(ssq, 32);
    if (hi == 0) red[w * 32 + r32] = ssq;
    __syncthreads();
    float tot = 0.f;
#pragma unroll
    for (int ww = 0; ww < 8; ++ww) tot += red[ww * 32 + r32];
    const float rstd = rsqrtf(tot * (1.f / 1024.f) + EPS);
    LAS bf16* stg = (LAS bf16*)F.lds + w * (32 * 136);
#pragma unroll
    for (int hh = 0; hh < 2; ++hh)
#pragma unroll
        for (int dh = 0; dh < 2; ++dh)
#pragma unroll
            for (int i4 = 0; i4 < 4; ++i4) { const int cl = hh * 64 + dh * 32 + 8 * i4 + 4 * hi; const f32x4 g = *(const f32x4*)(F.att_g + w * 128 + cl);
                u32x2 wv; wv.x = pk2(o[hh][dh][4 * i4 + 0] * rstd * g[0], o[hh][dh][4 * i4 + 1] * rstd * g[1]); wv.y = pk2(o[hh][dh][4 * i4 + 2] * rstd * g[2], o[hh][dh][4 * i4 + 3] * rstd * g[3]);
                *(LAS u32x2*)(stg + r32 * 136 + cl) = wv; }
    asm volatile("s_waitcnt lgkmcnt(0)" ::: "memory");
#pragma unroll
    for (int it = 0; it < 8; ++it) { const int row = it * 4 + (lane >> 4), ch = lane & 15;
        const u32x4 v = *(const LAS u32x4*)(stg + row * 136 + ch * 8);
        *(u32x4*)(Y + (size_t)(t0 + row) * D + DINNER + w * 128 + ch * 8) = v; }
    __syncthreads();
}
constexpr int XPN = 272, BPN = 144;
constexpr int L_X = 0, L_B = 128 * XPN * 2, L_C = L_B + 128 * BPN * 2, L_TDT = L_C + 128 * BPN * 2, L_TACS = L_TDT + 2048, L_RED = L_TACS + 2048;
static_assert(L_RED + 2048 <= LDS_BYTES, "LDS map of the SSD items");
constexpr size_t WS_PREV = WS_MISC, WS_CD = WS_MISC + 16 * MiB;
DI void ssd_tables(Frame& F, int row0, int g, LAS float* tdt, LAS float* tacs) {
    const float* DT = (const float*)(F.ws + WS_DT);
    const int hh = F.wave >> 1, s = (F.wave & 1) * 64 + F.lane, h = g * 4 + hh;
    const float dtv = softplus_f(DT[(size_t)(row0 + s) * 16 + h] + F.dt_bias[h]);
    float v = dtv * (-__expf(F.A_log[h]));
#pragma unroll
    for (int o = 1; o < 64; o <<= 1) { const float u = __shfl_up(v, o); if (F.lane >= o) v += u; }
    tdt[hh * 128 + s] = dtv; if (!(F.wave & 1)) tacs[hh * 128 + s] = v;
    __syncthreads();
    if (F.wave & 1) tacs[hh * 128 + s] = v + tacs[hh * 128 + 63];
    __syncthreads();
}
struct ConvRegs { bf16x8 v[19]; float wk[4][8]; float bb[8]; };
template <bool STATE> DI void conv_issue(Frame& F, const bf16* proj, int row0, int l00, int g, ConvRegs& R) {
    const int ck = F.lane, seg = F.wave;
    int ch0;
    if (ck < 32) ch0 = g * 256 + ck * 8; else if (ck < 48) ch0 = DINNER + g * 128 + (ck - 32) * 8; else ch0 = DINNER + 512 + g * 128 + (ck - 48) * 8;
    const bf16* src = proj + (size_t)(row0 + seg * 16 - 3) * NPROJ + PXBC + ch0;
#pragma unroll
    for (int r = 0; r < 19; ++r) { if (l00 + seg * 16 - 3 + r >= 0) R.v[r] = *(const bf16x8*)(src + (size_t)r * NPROJ); else R.v[r] = (bf16x8){0, 0, 0, 0, 0, 0, 0, 0}; }
#pragma unroll
    for (int k = 0; k < 4; ++k) { const f32x4 w0 = *(const f32x4*)(F.conv_w + k * CONVD + ch0), w1 = *(const f32x4*)(F.conv_w + k * CONVD + ch0 + 4);
#pragma unroll
        for (int e = 0; e < 4; ++e) { R.wk[k][e] = w0[e]; R.wk[k][4 + e] = w1[e]; } }
    { const f32x4 b0 = *(const f32x4*)(F.conv_b + ch0), b1 = *(const f32x4*)(F.conv_b + ch0 + 4);
#pragma unroll
      for (int e = 0; e < 4; ++e) { R.bb[e] = b0[e]; R.bb[4 + e] = b1[e]; } }
}
template <bool STATE> DI void conv_compute(Frame& F, const ConvRegs& R, const LAS float* tdt, const LAS float* tacs) {
    const int ck = F.lane, seg = F.wave;
    if (STATE && ck >= 48) return;
    int pitch, ccol, loff;
    if (ck < 32) { pitch = XPN; ccol = ck * 8; loff = L_X; }
    else if (ck < 48) { pitch = BPN; ccol = (ck - 32) * 8; loff = L_B; }
    else { pitch = BPN; ccol = (ck - 48) * 8; loff = L_C; }
    LAS bf16* dst = (LAS bf16*)(F.lds + loff);
    const int hh = ck >> 3;
#pragma unroll
    for (int i = 0; i < 16; ++i) { const int sr = seg * 16 + i; float o[8];
#pragma unroll
        for (int e = 0; e < 8; ++e) { float a = R.bb[e];
#pragma unroll
            for (int k = 0; k < 4; ++k) a += R.wk[k][e] * bf2f((bf16)R.v[i + k][e]);
            o[e] = silu_f(a); }
        if (STATE && ck < 32) { const float sc = tdt[hh * 128 + sr] * __expf(tacs[hh * 128 + 127] - tacs[hh * 128 + sr]);
#pragma unroll
            for (int e = 0; e < 8; ++e) o[e] *= sc; }
        u32x4 wv; wv.x = pk2(o[0], o[1]); wv.y = pk2(o[2], o[3]); wv.z = pk2(o[4], o[5]); wv.w = pk2(o[6], o[7]);
        *(LAS u32x4*)(dst + sr * pitch + ccol) = wv; }
}
DI void ssd_front(Frame& F, int item, f32x16 (&yd)[2][2]) {
    const bf16* proj = (const bf16*)(F.ws + WS_PROJ); float* ST = F.out; float* CD = (float*)(F.ws + WS_CD);
    const LAS bf16* Xs = (const LAS bf16*)(F.lds + L_X); const LAS bf16* Bs = (const LAS bf16*)(F.lds + L_B); const LAS bf16* Cs = (const LAS bf16*)(F.lds + L_C);
    LAS float* tdt = (LAS float*)(F.lds + L_TDT); LAS float* tacs = (LAS float*)(F.lds + L_TACS); LAS float* tw = (LAS float*)(F.lds + L_RED);
    const int b = item >> 6, c = (item >> 2) & 15, g = item & 3, row0 = b * SEQ + c * 128, l00 = c * 128;
    const int lane = F.lane, r32 = lane & 31, hi = lane >> 5, w = F.wave;
    ConvRegs cr; conv_issue<false>(F, proj, row0, l00, g, cr);
    ssd_tables(F, row0, g, tdt, tacs);
    { const int t = F.tid; tw[t] = tdt[t] * __expf(tacs[(t & ~127) + 127] - tacs[t]); }
    conv_compute<false>(F, cr, tdt, tacs);
    __syncthreads();
    const int hh = w >> 1, h = g * 4 + hh;
    {
        const int pt = w & 1;
        f32x16 acc[4];
#pragma unroll
        for (int nt = 0; nt < 4; ++nt)
#pragma unroll
            for (int i = 0; i < 16; ++i) acc[nt][i] = 0.f;
#pragma unroll
        for (int ks = 0; ks < 8; ++ks) { const bf16x8 ax = tr_frag(Xs, XPN, 16 * ks + 8 * hi, 16 * ks + 8 * hi + 4, hh * 64 + pt * 32, lane);
            const f32x4 w0 = *(const LAS f32x4*)(tw + hh * 128 + 16 * ks + 8 * hi), w1 = *(const LAS f32x4*)(tw + hh * 128 + 16 * ks + 8 * hi + 4);
            u32x4 pa; pa.x = pk2(bf2f((bf16)ax[0]) * w0[0], bf2f((bf16)ax[1]) * w0[1]); pa.y = pk2(bf2f((bf16)ax[2]) * w0[2], bf2f((bf16)ax[3]) * w0[3]);
            pa.z = pk2(bf2f((bf16)ax[4]) * w1[0], bf2f((bf16)ax[5]) * w1[1]); pa.w = pk2(bf2f((bf16)ax[6]) * w1[2], bf2f((bf16)ax[7]) * w1[3]);
            const bf16x8 af = __builtin_bit_cast(bf16x8, pa);
#pragma unroll
            for (int nt = 0; nt < 4; ++nt) { const bf16x8 bfr = tr_frag(Bs, BPN, 16 * ks + 8 * hi, 16 * ks + 8 * hi + 4, nt * 32, lane); acc[nt] = MFMA32(af, bfr, acc[nt]); } }
        float* stp = ST + (size_t)((b * 16 + c) * 16 + h) * 8192;
#pragma unroll
        for (int nt = 0; nt < 4; ++nt)
#pragma unroll
            for (int i = 0; i < 16; ++i) stp[(pt * 32 + crow(i, hi)) * 128 + nt * 32 + r32] = acc[nt][i];
        if (F.tid < 4) CD[(b * 16 + c) * 16 + g * 4 + F.tid] = __expf(tacs[F.tid * 128 + 127]);
    }
    const int pr = w & 1;
#pragma unroll
    for (int li = 0; li < 2; ++li) {
        const int lt = (li == 0) ? pr : 3 - pr, l = lt * 32 + r32;
        bf16x8 cf[8];
#pragma unroll
        for (int ks = 0; ks < 8; ++ks) cf[ks] = *(const LAS bf16x8*)(Cs + l * BPN + 16 * ks + 8 * hi);
        f32x16 acc[2];
#pragma unroll
        for (int pt = 0; pt < 2; ++pt)
#pragma unroll
            for (int i = 0; i < 16; ++i) acc[pt][i] = 0.f;
        const float al = tacs[hh * 128 + l];
#pragma unroll 1
        for (int st = 0; st <= lt; ++st) {
            f32x16 gT;
#pragma unroll
            for (int i = 0; i < 16; ++i) gT[i] = 0.f;
#pragma unroll
            for (int ks = 0; ks < 8; ++ks) { const bf16x8 bfr = *(const LAS bf16x8*)(Bs + (st * 32 + r32) * BPN + 16 * ks + 8 * hi); gT = MFMA32(bfr, cf[ks], gT); }
#pragma unroll
            for (int i = 0; i < 16; ++i) { const int s = st * 32 + crow(i, hi); const float v = gT[i] * __expf(al - tacs[hh * 128 + s]) * tdt[hh * 128 + s]; gT[i] = (s > l) ? 0.f : v; }
#pragma unroll
            for (int s2 = 0; s2 < 2; ++s2) { const bf16x8 mf = pack8(gT, s2);
#pragma unroll
                for (int pt = 0; pt < 2; ++pt) { const bf16x8 xa = tr_frag(Xs, XPN, st * 32 + 16 * s2 + 4 * hi, st * 32 + 16 * s2 + 4 * hi + 8, hh * 64 + pt * 32, lane); acc[pt] = MFMA32(xa, mf, acc[pt]); } }
        }
        yd[li][0] = acc[0]; yd[li][1] = acc[1];
        __builtin_amdgcn_sched_barrier(0);
    }
}
DI void ssd_scan(Frame& F) {
    const float* ST = F.out; const float* CD = (const float*)(F.ws + WS_CD); bf16* PREV = (bf16*)(F.ws + WS_PREV);
    for (int idx = F.blk * 512 + F.tid; idx < NBATCH * NH * 64 * 32; idx += F.G * 512) {
        const int n4 = idx & 31, p = (idx >> 5) & 63, h = (idx >> 11) & 15, b = idx >> 15;
        const size_t base0 = (size_t)(b * 256 + h) * 8192 + p * 128 + n4 * 4;
        f32x4 sv[15]; float d[15];
#pragma unroll
        for (int c = 0; c < 15; ++c) { sv[c] = *(const f32x4*)(ST + base0 + (size_t)c * 16 * 8192); d[c] = CD[(b * 16 + c) * 16 + h]; }
        f32x4 st = {0.f, 0.f, 0.f, 0.f};
#pragma unroll
        for (int c = 0; c < 16; ++c) { u32x2 wv; wv.x = pk2(st[0], st[1]); wv.y = pk2(st[2], st[3]); *(u32x2*)(PREV + base0 + (size_t)c * 16 * 8192) = wv;
            if (c < 15) st = st * d[c] + sv[c]; }
    }
}
DI void ssd_back(Frame& F, int item, f32x16 (&yd)[2][2]) {
    const bf16* proj = (const bf16*)(F.ws + WS_PROJ); bf16* Y = (bf16*)(F.ws + WS_Y); const bf16* PREV = (const bf16*)(F.ws + WS_PREV);
    const LAS bf16* Xs = (const LAS bf16*)(F.lds + L_X); const LAS bf16* Cs = (const LAS bf16*)(F.lds + L_C);
    LAS float* tacs = (LAS float*)(F.lds + L_TACS); LAS float* red = (LAS float*)(F.lds + L_RED);
    const int b = item >> 6, c = (item >> 2) & 15, g = item & 3, row0 = b * SEQ + c * 128;
    const int lane = F.lane, r32 = lane & 31, hi = lane >> 5, w = F.wave;
    const int hh = w >> 1, pr = w & 1, h = g * 4 + hh;
    const bf16* prevp = PREV + (size_t)((b * 16 + c) * 16 + h) * 8192;
    const float Dk = F.D_skip[h];
    bf16x8 pf[2][8];
#pragma unroll
    for (int ks = 0; ks < 8; ++ks)
#pragma unroll
        for (int pt = 0; pt < 2; ++pt) pf[pt][ks] = *(const bf16x8*)(prevp + (pt * 32 + r32) * 128 + 16 * ks + 8 * hi);
#pragma unroll
    for (int li = 0; li < 2; ++li) {
        const int lt = (li == 0) ? pr : 3 - pr, l = lt * 32 + r32;
        u32x2 zz[2][4];
#pragma unroll
        for (int pt = 0; pt < 2; ++pt)
#pragma unroll
            for (int i4 = 0; i4 < 4; ++i4) zz[pt][i4] = *(const u32x2*)(proj + (size_t)(row0 + l) * NPROJ + PZ + h * 64 + pt * 32 + 8 * i4 + 4 * hi);
        f32x16 acc[2];
#pragma unroll
        for (int pt = 0; pt < 2; ++pt)
#pragma unroll
            for (int i = 0; i < 16; ++i) acc[pt][i] = 0.f;
#pragma unroll
        for (int ks = 0; ks < 8; ++ks) { const bf16x8 cfk = *(const LAS bf16x8*)(Cs + l * BPN + 16 * ks + 8 * hi);
#pragma unroll
            for (int pt = 0; pt < 2; ++pt) acc[pt] = MFMA32(pf[pt][ks], cfk, acc[pt]); }
        const float el = __expf(tacs[hh * 128 + l]);
        float ss = 0.f;
#pragma unroll
        for (int pt = 0; pt < 2; ++pt)
#pragma unroll
            for (int i4 = 0; i4 < 4; ++i4) { const int p0 = pt * 32 + 8 * i4 + 4 * hi;
                const u32x2 xx = *(const LAS u32x2*)(Xs + l * XPN + hh * 64 + p0);
                const float z[4] = {__uint_as_float(zz[pt][i4].x << 16), __uint_as_float(zz[pt][i4].x & 0xffff0000u), __uint_as_float(zz[pt][i4].y << 16), __uint_as_float(zz[pt][i4].y & 0xffff0000u)};
                const float xv[4] = {__uint_as_float(xx.x << 16), __uint_as_float(xx.x & 0xffff0000u), __uint_as_float(xx.y << 16), __uint_as_float(xx.y & 0xffff0000u)};
#pragma unroll
                for (int e = 0; e < 4; ++e) { const float y = (yd[li][pt][4 * i4 + e] + el * acc[pt][4 * i4 + e] + Dk * xv[e]) * silu_f(z[e]); yd[li][pt][4 * i4 + e] = y; ss += y * y; } }
        ss += __shfl_xor(ss, 32);
        if (hi == 0) red[hh * 128 + l] = ss;
        __builtin_amdgcn_sched_barrier(0);
    }
    __syncthreads();
    LAS bf16* stg = (LAS bf16*)F.lds + w * (64 * 72);
#pragma unroll
    for (int li = 0; li < 2; ++li) {
        const int lt = (li == 0) ? pr : 3 - pr, l = lt * 32 + r32;
        const float rstd = rsqrtf(((red[l] + red[128 + l]) + (red[256 + l] + red[384 + l])) * (1.f / 256.f) + EPS);
#pragma unroll
        for (int pt = 0; pt < 2; ++pt)
#pragma unroll
            for (int i4 = 0; i4 < 4; ++i4) { const int cl = pt * 32 + 8 * i4 + 4 * hi; const f32x4 gg = *(const f32x4*)(F.ssm_g + h * 64 + cl);
                u32x2 wv; wv.x = pk2(yd[li][pt][4 * i4 + 0] * rstd * gg[0], yd[li][pt][4 * i4 + 1] * rstd * gg[1]); wv.y = pk2(yd[li][pt][4 * i4 + 2] * rstd * gg[2], yd[li][pt][4 * i4 + 3] * rstd * gg[3]);
                *(LAS u32x2*)(stg + (li * 32 + r32) * 72 + cl) = wv; }
    }
    asm volatile("s_waitcnt lgkmcnt(0)" ::: "memory");
#pragma unroll
    for (int it = 0; it < 8; ++it) { const int row = it * 8 + (lane >> 3), ch = lane & 7;
        const int lt = (row < 32) ? pr : 3 - pr, l = lt * 32 + (row & 31);
        const u32x4 v = *(const LAS u32x4*)(stg + row * 72 + ch * 8);
        *(u32x4*)(Y + (size_t)(row0 + l) * D + h * 64 + ch * 8) = v; }
    __syncthreads();
}

#define XB_TMO      128
#define XB_XCNT(j)  (256  + 64 * (j))
#define XB_XSUB(j)  (1280 + 64 * (j))
#define XB_XGEN(j)  (2304 + 64 * (j))
#define XB_TOP      3328
#define XB_TOPGEN   3392
#define XCD_BAR_WORDS 3456
#define XB_SPIN_CAP (1u << 18)
DI unsigned xb_ld(unsigned* p)              { return __hip_atomic_load(p, __ATOMIC_RELAXED, __HIP_MEMORY_SCOPE_AGENT); }
DI unsigned xb_add(unsigned* p, unsigned v) { return __hip_atomic_fetch_add(p, v, __ATOMIC_RELAXED, __HIP_MEMORY_SCOPE_AGENT); }
DI unsigned xb_xcc_id() { return (unsigned)__builtin_amdgcn_s_getreg((3 << 11) | 20) & 0xFu; }
#define XB_SPIN(cond, bar) do { unsigned _sp = 0; while (cond) { __builtin_amdgcn_s_sleep(1); \
    if ((++_sp & 255u) == 0u) { if (xb_ld(&(bar)[XB_TMO])) break; if (_sp > XB_SPIN_CAP) { atomicAdd(&(bar)[XB_TMO], 1u); break; } } } } while (0)
struct XcdBarrier { unsigned* bar; unsigned x; volatile LAS unsigned* st; };
DI XcdBarrier xcd_barrier_post(unsigned* bar, volatile LAS unsigned* st) {
    XcdBarrier b; b.bar = bar; b.x = xb_xcc_id(); b.st = st;
    if (threadIdx.x == 0) (void)xb_add(&bar[XB_XCNT(b.x)], 1u);
    return b;
}
DI void xcd_barrier_complete(unsigned* bar, unsigned x, unsigned& nloc, unsigned& nx) {
    const unsigned G = gridDim.x * gridDim.y * gridDim.z;
    unsigned sum, cnt, mine, sp = 0u;
    for (;;) {
        sum = 0u; cnt = 0u; mine = 0u;
#pragma unroll
        for (unsigned j = 0; j < 16; ++j) { const unsigned c = xb_ld(&bar[XB_XCNT(j)]); sum += c; cnt += (c > 0u) ? 1u : 0u; mine = (j == x) ? c : mine; }
        if (sum == G) break;
        __builtin_amdgcn_s_sleep(1);
        if ((++sp & 255u) == 0u) { if (xb_ld(&bar[XB_TMO])) break; if (sp > XB_SPIN_CAP) { atomicAdd(&bar[XB_TMO], 1u); break; } }
    }
    nloc = mine > 0u ? mine : 1u; nx = cnt > 0u ? cnt : 1u;
}
DI void xcd_barrier(const XcdBarrier& b) {
    asm volatile("s_waitcnt vmcnt(0)" ::: "memory");
    __syncthreads();
    if (threadIdx.x == 0) {
        unsigned* bar = b.bar;
        __builtin_amdgcn_s_waitcnt(0);
        unsigned nloc = b.st[0], nx = b.st[1];
        if (nloc == 0u) { xcd_barrier_complete(bar, b.x, nloc, nx); b.st[0] = nloc; b.st[1] = nx; }
        const unsigned old = xb_add(&bar[XB_XSUB(b.x)], 1u);
        const unsigned gen = old / nloc;
        if (old + 1u == (gen + 1u) * nloc) {
            __builtin_amdgcn_fence(__ATOMIC_RELEASE, "agent");
            asm volatile("s_waitcnt vmcnt(0)" ::: "memory");
            const unsigned og = xb_add(&bar[XB_TOP], 1u);
            const unsigned tg = og / nx;
            if (og + 1u == (tg + 1u) * nx) xb_add(&bar[XB_TOPGEN], 1u);
            else XB_SPIN(xb_ld(&bar[XB_TOPGEN]) == tg, bar);
            __builtin_amdgcn_fence(__ATOMIC_ACQUIRE, "agent");
            xb_add(&bar[XB_XGEN(b.x)], 1u);
            asm volatile("s_waitcnt vmcnt(0)" ::: "memory");
        } else {
            XB_SPIN(xb_ld(&bar[XB_XGEN(b.x)]) == gen, bar);
            __builtin_amdgcn_fence(__ATOMIC_ACQUIRE, "agent");
            asm volatile("s_waitcnt vmcnt(0)" ::: "memory");
        }
    }
    __syncthreads();
}

__global__ void __launch_bounds__(512, 2) mk_fwd(Args args) {
    extern __shared__ __attribute__((aligned(16))) unsigned char lds_raw[];
    Frame F;
    F.lds = (LAS unsigned char*)lds_raw;
    F.tid = threadIdx.x; F.lane = F.tid & 63; F.wave = __builtin_amdgcn_readfirstlane(F.tid >> 6); F.G = gridDim.x; F.blk = blockIdx.x;
    F.x = args.in[0]; F.mix_g = args.in[1]; F.w_in = args.in[2]; F.conv_w = args.in[3]; F.conv_b = args.in[4]; F.dt_bias = args.in[5]; F.A_log = args.in[6]; F.D_skip = args.in[7];
    F.ssm_g = args.in[8]; F.sinks = args.in[9]; F.att_g = args.in[10]; F.w_out = args.in[11]; F.mlp_g = args.in[12]; F.w_up = args.in[13]; F.w_down = args.in[14]; F.fin_g = args.in[15];
    F.out = args.out; F.ws = args.ws;
    bf16* XN = (bf16*)(F.ws + WS_XN); bf16* PROJ = (bf16*)(F.ws + WS_PROJ); bf16* Y = (bf16*)(F.ws + WS_Y); bf16* H = (bf16*)(F.ws + WS_H);
    float* SSQ1 = (float*)(F.ws + WS_SSQ1); float* SSQ2 = (float*)(F.ws + WS_SSQ2);
    if (F.tid < 16) ((LAS unsigned*)(F.lds + MISC_OFF))[F.tid] = 0u;
    __syncthreads();
    const XcdBarrier xbar = xcd_barrier_post((unsigned*)F.ws, (volatile LAS unsigned*)(F.lds + MISC_OFF));
    f32x16 yd[2][2];
#pragma unroll
    for (int a_ = 0; a_ < 2; ++a_)
#pragma unroll
        for (int b_ = 0; b_ < 2; ++b_)
#pragma unroll
            for (int i_ = 0; i_ < 16; ++i_) yd[a_][b_][i_] = 0.f;
    const int lo = args.ph_lo, hi = args.ph_hi;
    if (hi > 1000) cg::this_grid().sync();
#define IN(k) (lo <= (k) && (k) < hi)
#define SEAM(k) do { if (IN(k) && IN((k) + 1)) { xcd_barrier(xbar); } } while (0)
#define PH0() if (IN(0)) { p0_prologue(F); } SEAM(0);
#define PH1() if (IN(1)) { \
        pg8::Gemm g{XN, (const bf16*)(F.ws + WS_WIN), M, NPROJ, D}; pg8::StaticOrder S; S.init(M, NPROJ, F.G, F.blk); S.rebal = (F.G == 256) ? 1 : 0; \
        pg8::Epi<0> E{PROJ, NPROJ, nullptr, nullptr, nullptr, nullptr, nullptr}; \
        pg8::gemm_phase(F.lds, g, S, E); \
        dt_gemm(F); p0b_weights(F); } SEAM(1);
#define PH2() if (IN(2)) { if (F.blk < 256) { attn_item(F, F.blk); if (MK_PROBE_PHASE == 21) attn_item(F, F.blk); ssd_front(F, F.blk, yd); } } SEAM(2); \
    if (MK_PROBE_PHASE == 30) { for (int q_ = 0; q_ < 10; ++q_) xcd_barrier(xbar); } \
    if (IN(3)) { ssd_scan(F); } SEAM(3); \
    if (IN(4)) { if (F.blk < 256) ssd_back(F, F.blk, yd); } SEAM(4);
#define PH5() if (IN(5)) { \
        pg8::Gemm g{Y, (const bf16*)(F.ws + WS_WOUT), M, D, D}; pg8::StaticOrder S; S.init(M, D, F.G, F.blk); \
        pg8::Epi<1> E{XN, D, F.x, nullptr, SSQ1, nullptr, nullptr}; \
        pg8::gemm_phase(F.lds, g, S, E); } SEAM(5);
#define PH6() if (IN(6)) { \
        pg8::Gemm g{XN, (const bf16*)(F.ws + WS_WUP), M, FF, D}; pg8::StaticOrder S; S.init(M, FF, F.G, F.blk); \
        pg8::Epi<2> E{H, FF, nullptr, nullptr, nullptr, SSQ1, nullptr}; \
        pg8::gemm_phase(F.lds, g, S, E); } SEAM(6);
    PH0();
#if MK_PROBE_PHASE == 0
    PH0();
#endif
    PH1();
#if MK_PROBE_PHASE == 1
    PH1();
#endif
    PH2();
#if MK_PROBE_PHASE == 2
    PH2();
#endif
    PH5();
#if MK_PROBE_PHASE == 5
    PH5();
#endif
    PH6();
#if MK_PROBE_PHASE == 6
    PH6();
#endif
#define PH7() if (IN(7)) { \
        pg8::Gemm g{H, (const bf16*)(F.ws + WS_WDN), M, D, FF}; pg8::StaticOrder S; S.init(M, D, F.G, F.blk); \
        pg8::Epi<3> E{XN, D, F.fin_g, F.out, SSQ2, nullptr, (unsigned*)F.ws + 4096}; \
        pg8::gemm_phase(F.lds, g, S, E); }
    PH7();
#if MK_PROBE_PHASE == 7
    xcd_barrier(xbar);
    PH7();
#endif
}


extern "C" void kernel_launch(void* const* d_in, const int* in_sizes, int n_in, void* d_out, int out_size, void* d_ws, size_t ws_size, hipStream_t stream) {
    static int grid = 0;
    if (grid == 0) {
        int dev = 0, cus = 0, per_cu = 0;
        (void)hipGetDevice(&dev); (void)hipDeviceGetAttribute(&cus, hipDeviceAttributeMultiprocessorCount, dev);
        if (hipFuncSetAttribute((const void*)mk_fwd, hipFuncAttributeMaxDynamicSharedMemorySize, LDS_BYTES) != hipSuccess) { fprintf(stderr, "hipFuncSetAttribute failed\n"); }
        if (hipOccupancyMaxActiveBlocksPerMultiprocessor(&per_cu, (const void*)mk_fwd, 512, LDS_BYTES) != hipSuccess || per_cu < 1) per_cu = 1;
        (void)hipGetLastError();
        if (per_cu > 1) per_cu = 1;
        grid = cus * per_cu;
        if (grid <= 0) grid = 256;
        if (grid != 256) fprintf(stderr, "kernel_launch: grid %d != 256: the fused final norm needs one down-GEMM unit per workgroup\n", grid);
    }
    Args a{};
    for (int i = 0; i < 16; ++i) a.in[i] = (const float*)d_in[i];
    a.out = (float*)d_out; a.ws = (unsigned char*)d_ws;
    a.ph_lo = 0; a.ph_hi = 9;
    (void)hipMemsetAsync(d_ws, 0, 32768, stream);
    void* kargs[] = {&a};
    hipError_t e = hipLaunchCooperativeKernel((const void*)mk_fwd, dim3(grid), dim3(512), kargs, LDS_BYTES, stream);
    if (e != hipSuccess) fprintf(stderr, "cooperative launch failed: %s (grid %d)\n", hipGetErrorString(e), grid);
}
```

```cpp
#include <hip/hip_runtime.h>
#include <hip/hip_cooperative_groups.h>
#include <cstdio>
#include <cstdint>
namespace cg = cooperative_groups;

#ifndef MK_PROBE_PHASE
#define MK_PROBE_PHASE -1
#endif

#define DI __device__ __forceinline__
#define LAS __attribute__((address_space(3)))
typedef unsigned short bf16;
typedef short bf16x8 __attribute__((ext_vector_type(8)));
typedef float f32x4 __attribute__((ext_vector_type(4)));
typedef float f32x2 __attribute__((ext_vector_type(2)));
typedef unsigned u32x4 __attribute__((ext_vector_type(4)));
typedef unsigned u32x2 __attribute__((ext_vector_type(2)));
typedef float f32x16 __attribute__((ext_vector_type(16)));
typedef __bf16 bf16x2_t __attribute__((ext_vector_type(2)));

constexpr int M = 8192, D = 2048, SEQ = 2048, NBATCH = 4;
constexpr int NIN = 4368, NPROJ = 4352;
constexpr int PZ = 0, PXBC = 1024, PQ = 3072, PK = 4096, PV = 4224;
constexpr int DT_COL = 3072;
constexpr int NH = 16, HD = 64, NG = 4, NS = 128, DINNER = 1024, CONVD = 2048;
constexpr int FF = 8192;
constexpr float EPS = 1e-5f;

constexpr size_t MiB = 1u << 20;
constexpr size_t WS_WUP = 2 * MiB, WS_WDN = 34 * MiB, WS_XN = 66 * MiB;
constexpr size_t WS_SSQ1 = 98 * MiB, WS_SSQ2 = 98 * MiB + 256 * 1024, WS_DT = 98 * MiB + 512 * 1024;
constexpr size_t WS_H = 100 * MiB;
constexpr size_t WS_WIN = 100 * MiB, WS_WDT = 117 * MiB, WS_WOUT = 118 * MiB, WS_PROJ = 126 * MiB, WS_Y = 194 * MiB;
constexpr size_t WS_MISC = 228 * MiB;

constexpr int RING_BYTES = 131072, XLDS_OFF = RING_BYTES, LDS_BYTES = 149504 + 64, MISC_OFF = 149504;

DI float bf2f(bf16 v) { return __uint_as_float(((unsigned)v) << 16); }
DI unsigned f2bf(float f) { unsigned u = __float_as_uint(f); return (u + 0x7fffu + ((u >> 16) & 1u)) >> 16; }
DI unsigned pk2(float lo, float hi) { f32x2 v = {lo, hi}; bf16x2_t b = __builtin_convertvector(v, bf16x2_t); return __builtin_bit_cast(unsigned, b); }
DI float wave_sum(float v) {
#pragma unroll
    for (int o = 1; o < 64; o <<= 1) v += __shfl_xor(v, o);
    return v;
}
DI float silu_f(float x) { return x * __builtin_amdgcn_rcpf(1.f + __expf(-x)); }
DI float softplus_f(float x) { return x > 20.f ? x : log1pf(__expf(x)); }

namespace pg8 {
constexpr int BM = 256, BK = 64, HALF = 128, HTB = HALF * BK * 2, NXCD = 8, WGM = 8;
__host__ __device__ __forceinline__ int lds_byte(int r, int c) { const int st = (r >> 4) * 2 + (c >> 5), rr = r & 15, cc = c & 31, ob = rr * 64 + cc * 2; return st * 1024 + (ob ^ (((ob >> 9) & 1) << 5)); }
__host__ __device__ __forceinline__ void stage_rc(int b, int& R, int& C) { const int st = b / 1024, sb = b % 1024, swz = sb ^ (((sb >> 9) & 1) << 5); R = (st >> 1) * 16 + swz / 64; C = (st & 1) * 32 + (swz % 64) / 2; }
__host__ __device__ __forceinline__ int perm32(int rho) { const int n = rho >> 4, i = rho & 15; return 8 * (i >> 2) + 4 * n + (i & 3); }

struct Unit { int pm, pn; };
struct Gemm { const bf16* A; const bf16* Bt; int M, N, K; };
struct StaticOrder {
    int nM, nN, nwg, G, c;
    DI void init(int M_, int N_, int G_, int c_) { nM = M_ / BM; nN = N_ / BM; nwg = nM * nN; G = G_; c = c_; rebal = 0; }
    int rebal;
    DI bool next(int i, Unit& u) const {
        long L = (long)i * G + c;
        if (rebal) { if (i == 0) L = c; else if (i == 1) { if (c >= 144) return false; L = 256 + c; } else if (i == 2) { if (c >= 144) return false; L = 400 + c; } else return false; }
        if (L >= nwg) return false;
        int wgid = (int)L; { const int q = nwg / NXCD, r = nwg % NXCD, xcd = wgid % NXCD, off = wgid / NXCD; wgid = (xcd < r ? xcd * (q + 1) : r * (q + 1) + (xcd - r) * q) + off; }
        const int nig = WGM * nN, gid = wgid / nig, fm = gid * WGM, gsz = (nM - fm) < WGM ? (nM - fm) : WGM;
        u.pm = fm + ((wgid % nig) % gsz); u.pn = (wgid % nig) / gsz; return true;
    }
};

template <class Epi>
DI void gemm_phase(LAS unsigned char* lds, const Gemm g, const StaticOrder& S, const Epi& E) {
    const int tid = threadIdx.x, wid = __builtin_amdgcn_readfirstlane(tid >> 6), lane = tid & 63, wr = wid >> 2, wc = wid & 3, fr = lane & 15, fq = lane >> 4;
    const int K = g.K, nt = K / BK;
    unsigned voffA[2], voffB[2];
#pragma unroll
    for (int i = 0; i < 2; ++i) { int R, C; stage_rc(tid * 16 + i * 8192, R, C); const int Rb = (R & ~31) + perm32(R & 31);
        voffA[i] = (unsigned)(R * K + C) * 2u; voffB[i] = (unsigned)(Rb * K + C) * 2u; }
    const size_t kstep = (size_t)(BK * 2);
    const size_t hstep = (size_t)HALF * K * 2;
    const size_t tstep = 2 * hstep;
    const unsigned ldsw = (unsigned)wid * 1024u;
    const int aoff = lds_byte(wr * 64 + fr, fq * 8), boff = lds_byte(wc * 32 + fr, fq * 8);
#define PG8_SA(b, h) (((b) * 2 + (h)) * HTB)
#define PG8_SB(b, h) ((4 + (b) * 2 + (h)) * HTB)
#define PG8_STAGE(bufoff, gbase, voff) do { _Pragma("unroll") for (int _i = 0; _i < 2; ++_i) \
        __builtin_amdgcn_global_load_lds((const unsigned*)((const char*)(gbase) + (voff)[_i]), (LAS unsigned*)(lds + (bufoff) + ldsw + _i * 8192), 16, 0, 0); } while (0)
#define PG8_LDA(dst, b, h) do { _Pragma("unroll") for (int m = 0; m < 4; ++m) _Pragma("unroll") for (int k = 0; k < 2; ++k) dst[m][k] = *(const LAS bf16x8*)(lds + PG8_SA(b, h) + aoff + m * 2048 + k * 1024); } while (0)
#define PG8_LDB(dst, b, h) do { _Pragma("unroll") for (int n = 0; n < 2; ++n) _Pragma("unroll") for (int k = 0; k < 2; ++k) dst[n][k] = *(const LAS bf16x8*)(lds + PG8_SB(b, h) + boff + n * 2048 + k * 1024); } while (0)
#define PG8_MMA(ai, bj, At, Bt) do { __builtin_amdgcn_s_setprio(1); _Pragma("unroll") for (int m = 0; m < 4; ++m) _Pragma("unroll") for (int n = 0; n < 2; ++n) _Pragma("unroll") for (int k = 0; k < 2; ++k) \
        acc[ai][bj][m][n] = __builtin_amdgcn_mfma_f32_16x16x32_bf16(Bt[n][k], At[m][k], acc[ai][bj][m][n], 0, 0, 0); __builtin_amdgcn_s_setprio(0); } while (0)
#define PG8_WAIT_V(n) asm volatile("s_waitcnt vmcnt(" #n ")" ::: "memory")
#define PG8_WAIT_L(n) asm volatile("s_waitcnt lgkmcnt(" #n ")" ::: "memory")
#define PG8_BAR __builtin_amdgcn_s_barrier()
#define PG8_SCHED __builtin_amdgcn_sched_barrier(0)
    Unit cur, nxt; int ui = 0;
    if (!S.next(0, cur)) return;
    f32x4 acc[2][2][4][2];
#pragma unroll
    for (int a = 0; a < 2; ++a)
#pragma unroll
        for (int b = 0; b < 2; ++b)
#pragma unroll
            for (int m = 0; m < 4; ++m)
#pragma unroll
                for (int n = 0; n < 2; ++n) acc[a][b][m][n] = (f32x4){0.f, 0.f, 0.f, 0.f};
    bf16x8 At[4][2], B0[2][2], B1[2][2];
    const char* cA = (const char*)g.A + (size_t)cur.pm * tstep; const char* cB = (const char*)g.Bt + (size_t)cur.pn * tstep;
    PG8_STAGE(PG8_SB(0, 0), cB, voffB); PG8_STAGE(PG8_SB(0, 1), cB + hstep, voffB); PG8_STAGE(PG8_SA(0, 0), cA, voffA); PG8_STAGE(PG8_SA(0, 1), cA + hstep, voffA);
    if (wr == 1) PG8_BAR;
    PG8_WAIT_V(2); PG8_BAR;
    PG8_STAGE(PG8_SB(1, 0), cB + kstep, voffB); PG8_STAGE(PG8_SA(1, 0), cA + kstep, voffA); PG8_STAGE(PG8_SB(1, 1), cB + hstep + kstep, voffB);
    PG8_WAIT_V(6); PG8_BAR;
    for (;;) {
        const bool has_next = S.next(ui + 1, nxt);
        const char* nA = has_next ? (const char*)g.A + (size_t)nxt.pm * tstep : cA; const char* nB = has_next ? (const char*)g.Bt + (size_t)nxt.pn * tstep : cB;
        for (int t = 0; t < nt; t += 2) {
            const bool last = (t == nt - 2);
            const char* a1 = cA + (size_t)(t + 1) * kstep;
            const char* a2 = last ? nA : cA + (size_t)(t + 2) * kstep; const char* b2 = last ? nB : cB + (size_t)(t + 2) * kstep;
            const char* a3 = a2 + kstep; const char* b3 = b2 + kstep;
            PG8_LDB(B0, 0, 0); PG8_LDB(B1, 0, 1); PG8_SCHED; PG8_LDA(At, 0, 0); PG8_STAGE(PG8_SA(1, 1), a1 + hstep, voffA);
            PG8_WAIT_V(8); PG8_WAIT_L(0); PG8_BAR; PG8_MMA(0, 0, At, B0); PG8_MMA(0, 1, At, B1); PG8_BAR; PG8_SCHED;
            PG8_LDA(At, 0, 1); PG8_STAGE(PG8_SB(0, 0), b2, voffB); PG8_STAGE(PG8_SB(0, 1), b2 + hstep, voffB); PG8_STAGE(PG8_SA(0, 0), a2, voffA);
            PG8_WAIT_V(8); PG8_WAIT_L(0); PG8_BAR; PG8_MMA(1, 0, At, B0); PG8_MMA(1, 1, At, B1); PG8_BAR; PG8_SCHED;
            PG8_LDB(B0, 1, 0); PG8_LDB(B1, 1, 1); PG8_SCHED; PG8_LDA(At, 1, 0); PG8_STAGE(PG8_SA(0, 1), a2 + hstep, voffA);
            PG8_WAIT_V(8); PG8_WAIT_L(0); PG8_BAR; PG8_MMA(0, 0, At, B0); PG8_MMA(0, 1, At, B1); PG8_BAR; PG8_SCHED;
            PG8_LDA(At, 1, 1); PG8_STAGE(PG8_SB(1, 0), b3, voffB); PG8_STAGE(PG8_SB(1, 1), b3 + hstep, voffB); PG8_STAGE(PG8_SA(1, 0), a3, voffA);
            PG8_WAIT_V(8); PG8_WAIT_L(0); PG8_BAR; PG8_MMA(1, 0, At, B0); PG8_MMA(1, 1, At, B1); PG8_BAR; PG8_SCHED;
        }
        if (wr == 0) PG8_BAR;
        E(acc, cur, wr, wc, fr, fq, lds + XLDS_OFF);
        if (!has_next) break;
#pragma unroll
        for (int a = 0; a < 2; ++a)
#pragma unroll
            for (int b = 0; b < 2; ++b)
#pragma unroll
                for (int m = 0; m < 4; ++m)
#pragma unroll
                    for (int n = 0; n < 2; ++n) acc[a][b][m][n] = (f32x4){0.f, 0.f, 0.f, 0.f};
        cur = nxt; cA = nA; cB = nB; ++ui;
        if (wr == 1) PG8_BAR;
    }
    PG8_WAIT_V(0);
    PG8_BAR;
#undef PG8_SA
#undef PG8_SB
#undef PG8_STAGE
#undef PG8_LDA
#undef PG8_LDB
#undef PG8_MMA
#undef PG8_WAIT_V
#undef PG8_WAIT_L
#undef PG8_BAR
#undef PG8_SCHED
}

template <int MODE> struct Epi {
    bf16* O; int ldc; const float* base; float* outf; float* ssq; const float* ssq_in; unsigned* cnt;
    DI void operator()(f32x4 (&acc)[2][2][4][2], const Unit& u, int wr, int wc, int fr, int fq, LAS unsigned char* xl) const {
        const int row0 = u.pm * BM + wr * 64 + fr, col0 = u.pn * BM + wc * 32 + 8 * fq;
        if (MODE == 0) {
#pragma unroll
            for (int ai = 0; ai < 2; ++ai)
#pragma unroll
                for (int m = 0; m < 4; ++m) { bf16* rowp = O + (size_t)(row0 + ai * HALF + m * 16) * ldc + col0;
#pragma unroll
                    for (int bj = 0; bj < 2; ++bj) { const f32x4 v0 = acc[ai][bj][m][0], v1 = acc[ai][bj][m][1];
                        u32x4 w; w.x = pk2(v0[0], v0[1]); w.y = pk2(v0[2], v0[3]); w.z = pk2(v1[0], v1[1]); w.w = pk2(v1[2], v1[3]);
                        *(u32x4*)(rowp + bj * HALF) = w; } }
        } else if (MODE == 1) {
            LAS float* P = (LAS float*)xl;
#pragma unroll
            for (int ai = 0; ai < 2; ++ai)
#pragma unroll
                for (int m = 0; m < 4; ++m) { const int rl = ai * HALF + wr * 64 + m * 16 + fr; const size_t off = (size_t)(u.pm * BM + rl) * ldc + col0; float ss = 0.f;
#pragma unroll
                    for (int bj = 0; bj < 2; ++bj) {
                        const f32x4 x0 = *(const f32x4*)(base + off + bj * HALF), x1 = *(const f32x4*)(base + off + bj * HALF + 4);
                        const f32x4 v0 = acc[ai][bj][m][0] + x0, v1 = acc[ai][bj][m][1] + x1;
                        if (outf) { *(f32x4*)(outf + off + bj * HALF) = v0; *(f32x4*)(outf + off + bj * HALF + 4) = v1; }
                        if (O) { u32x4 w; w.x = pk2(v0[0], v0[1]); w.y = pk2(v0[2], v0[3]); w.z = pk2(v1[0], v1[1]); w.w = pk2(v1[2], v1[3]); *(u32x4*)(O + off + bj * HALF) = w; }
                        ss += (v0[0] * v0[0] + v0[1] * v0[1]) + (v0[2] * v0[2] + v0[3] * v0[3]) + (v1[0] * v1[0] + v1[1] * v1[1]) + (v1[2] * v1[2] + v1[3] * v1[3]);
                    }
                    ss += __shfl_xor(ss, 16); ss += __shfl_xor(ss, 32);
                    if (fq == 0) P[rl * 4 + wc] = ss; }
            asm volatile("s_waitcnt lgkmcnt(0)" ::: "memory"); __builtin_amdgcn_s_barrier(); asm volatile("" ::: "memory");
            if (threadIdx.x < 256) { const int t = threadIdx.x; const float s = (P[t * 4 + 0] + P[t * 4 + 1]) + (P[t * 4 + 2] + P[t * 4 + 3]); ssq[(size_t)(u.pm * BM + t) * 8 + u.pn] = s; }
            asm volatile("s_waitcnt lgkmcnt(0)" ::: "memory"); __builtin_amdgcn_s_barrier(); asm volatile("" ::: "memory");
        } else if (MODE == 3) {
            LAS float* P = (LAS float*)xl; LAS float* R = (LAS float*)(xl + 4096);
#pragma unroll
            for (int ai = 0; ai < 2; ++ai)
#pragma unroll
                for (int m = 0; m < 4; ++m) { const int rl = ai * HALF + wr * 64 + m * 16 + fr; const size_t off = (size_t)(u.pm * BM + rl) * ldc + col0; float ss = 0.f;
#pragma unroll
                    for (int bj = 0; bj < 2; ++bj) { const u32x4 xb = *(const u32x4*)(O + off + bj * HALF);
                        f32x4 v0 = acc[ai][bj][m][0], v1 = acc[ai][bj][m][1];
                        v0[0] += __uint_as_float(xb.x << 16); v0[1] += __uint_as_float(xb.x & 0xffff0000u); v0[2] += __uint_as_float(xb.y << 16); v0[3] += __uint_as_float(xb.y & 0xffff0000u);
                        v1[0] += __uint_as_float(xb.z << 16); v1[1] += __uint_as_float(xb.z & 0xffff0000u); v1[2] += __uint_as_float(xb.w << 16); v1[3] += __uint_as_float(xb.w & 0xffff0000u);
                        acc[ai][bj][m][0] = v0; acc[ai][bj][m][1] = v1;
                        ss += (v0[0] * v0[0] + v0[1] * v0[1]) + (v0[2] * v0[2] + v0[3] * v0[3]) + (v1[0] * v1[0] + v1[1] * v1[1]) + (v1[2] * v1[2] + v1[3] * v1[3]); }
                    ss += __shfl_xor(ss, 16); ss += __shfl_xor(ss, 32);
                    if (fq == 0) P[rl * 4 + wc] = ss; }
            asm volatile("s_waitcnt lgkmcnt(0)" ::: "memory"); __builtin_amdgcn_s_barrier(); asm volatile("" ::: "memory");
            const int t = threadIdx.x;
            if (t < 256) { const float sp = (P[t * 4 + 0] + P[t * 4 + 1]) + (P[t * 4 + 2] + P[t * 4 + 3]);
                __hip_atomic_store(ssq + (size_t)(u.pm * BM + t) * 8 + u.pn, sp, __ATOMIC_RELAXED, __HIP_MEMORY_SCOPE_AGENT); }
            asm volatile("s_waitcnt vmcnt(0)" ::: "memory"); __builtin_amdgcn_s_barrier(); asm volatile("" ::: "memory");
            if (t == 0) {
                __hip_atomic_fetch_add(cnt + 64 * u.pm, 1u, __ATOMIC_RELAXED, __HIP_MEMORY_SCOPE_AGENT);
                unsigned sp_ = 0;
                while (__hip_atomic_load(cnt + 64 * u.pm, __ATOMIC_RELAXED, __HIP_MEMORY_SCOPE_AGENT) < 8u) { __builtin_amdgcn_s_sleep(1); if (++sp_ > (1u << 22)) break; }
                __builtin_amdgcn_fence(__ATOMIC_ACQUIRE, "agent");
            }
            asm volatile("s_waitcnt vmcnt(0) lgkmcnt(0)" ::: "memory"); __builtin_amdgcn_s_barrier(); asm volatile("" ::: "memory");
            if (t < 256) { float tot = 0.f;
#pragma unroll
                for (int j = 0; j < 8; ++j) tot += __hip_atomic_load(ssq + (size_t)(u.pm * BM + t) * 8 + j, __ATOMIC_RELAXED, __HIP_MEMORY_SCOPE_AGENT);
                R[t] = rsqrtf(tot * (1.f / 2048.f) + EPS); }
            asm volatile("s_waitcnt vmcnt(0) lgkmcnt(0)" ::: "memory"); __builtin_amdgcn_s_barrier(); asm volatile("" ::: "memory");
            f32x4 gv[2][2];
#pragma unroll
            for (int bj = 0; bj < 2; ++bj) { gv[bj][0] = *(const f32x4*)(base + col0 + bj * HALF); gv[bj][1] = *(const f32x4*)(base + col0 + bj * HALF + 4); }
#pragma unroll
            for (int ai = 0; ai < 2; ++ai)
#pragma unroll
                for (int m = 0; m < 4; ++m) { const int rl = ai * HALF + wr * 64 + m * 16 + fr; const size_t off = (size_t)(u.pm * BM + rl) * ldc + col0; const float rstd = R[rl];
#pragma unroll
                    for (int bj = 0; bj < 2; ++bj) { *(f32x4*)(outf + off + bj * HALF) = acc[ai][bj][m][0] * rstd * gv[bj][0]; *(f32x4*)(outf + off + bj * HALF + 4) = acc[ai][bj][m][1] * rstd * gv[bj][1]; } }
        } else {
#pragma unroll
            for (int ai = 0; ai < 2; ++ai)
#pragma unroll
                for (int m = 0; m < 4; ++m) { const int row = row0 + ai * HALF + m * 16;
                    const f32x4 s0 = *(const f32x4*)(ssq_in + (size_t)row * 8), s1 = *(const f32x4*)(ssq_in + (size_t)row * 8 + 4);
                    const float rstd = rsqrtf(((s0[0] + s0[1]) + (s0[2] + s0[3]) + (s1[0] + s1[1]) + (s1[2] + s1[3])) * (1.f / 2048.f) + EPS);
                    bf16* rowp = O + (size_t)row * ldc + col0;
#pragma unroll
                    for (int bj = 0; bj < 2; ++bj) { f32x4 v0 = acc[ai][bj][m][0] * rstd, v1 = acc[ai][bj][m][1] * rstd;
#pragma unroll
                        for (int e = 0; e < 4; ++e) { const float a = fmaxf(v0[e], 0.f), b = fmaxf(v1[e], 0.f); v0[e] = a * a; v1[e] = b * b; }
                        u32x4 w; w.x = pk2(v0[0], v0[1]); w.y = pk2(v0[2], v0[3]); w.z = pk2(v1[0], v1[1]); w.w = pk2(v1[2], v1[3]);
                        *(u32x4*)(rowp + bj * HALF) = w; } }
        }
    }
};
}

struct Args { const float* in[16]; float* out; unsigned char* ws; int ph_lo, ph_hi; };

struct Frame {
    LAS unsigned char* lds; int tid, lane, wave, G, blk;
    const float *x, *mix_g, *w_in, *conv_w, *conv_b, *dt_bias, *A_log, *D_skip, *ssm_g, *sinks, *att_g, *w_out, *mlp_g, *w_up, *w_down, *fin_g;
    float* out; unsigned char* ws;
};

DI void p0_transpose_item(const float* W, int ldw, int src_col0, bf16* WT, int K, int dst_row0, const float* gs, LAS float* scr, int kb, int nb, int lane) {
    const int k0 = 64 * kb, n0 = 32 * nb;
    float v[32];
#pragma unroll
    for (int i = 0; i < 32; ++i) { const int kk = 2 * i + (lane >> 5); v[i] = __builtin_nontemporal_load(W + (size_t)(k0 + kk) * ldw + src_col0 + n0 + (lane & 31)); }
    if (gs) {
#pragma unroll
        for (int i = 0; i < 32; ++i) v[i] *= gs[k0 + 2 * i + (lane >> 5)]; }
#pragma unroll
    for (int i = 0; i < 32; ++i) scr[(2 * i + (lane >> 5)) * 33 + (lane & 31)] = v[i];
    asm volatile("s_waitcnt lgkmcnt(0)" ::: "memory");
    const int c = lane & 7;
#pragma unroll
    for (int j = 0; j < 4; ++j) { const int n = (lane >> 3) + 8 * j; const LAS float* s = scr + (8 * c) * 33 + n;
        u32x4 o; o.x = pk2(s[0 * 33], s[1 * 33]); o.y = pk2(s[2 * 33], s[3 * 33]); o.z = pk2(s[4 * 33], s[5 * 33]); o.w = pk2(s[6 * 33], s[7 * 33]);
        *(u32x4*)(WT + (size_t)(dst_row0 + n0 + n) * K + k0 + 8 * c) = o; }
    asm volatile("s_waitcnt lgkmcnt(0)" ::: "memory");
}
DI void p0_prologue(Frame& F) {
    LAS float* scr = (LAS float*)(F.lds + F.wave * 16384);
    const int gw = F.blk * 8 + F.wave, NGW = F.G * 8;
    bf16* Win_t = (bf16*)(F.ws + WS_WIN);
    bf16* Wdt_t = (bf16*)(F.ws + WS_WDT); bf16* XN = (bf16*)(F.ws + WS_XN);
    constexpr int I_A = 32 * 96, I_B = 32 * 40;
    constexpr int NITEMS = I_A + I_B;
    for (int it = gw; it < NITEMS; it += NGW) {
        int r = it;
        if (r < I_A) { p0_transpose_item(F.w_in, NIN, 0, Win_t, D, 0, nullptr, scr, r / 96, r % 96, F.lane); continue; } r -= I_A;
        p0_transpose_item(F.w_in, NIN, DT_COL + 16, Win_t, D, DT_COL, nullptr, scr, r / 40, r % 40, F.lane);
    }
    for (int i = F.blk * 512 + F.tid; i < 16 * D; i += F.G * 512) { const int j = i / D, k = i % D; Wdt_t[i] = (bf16)f2bf(F.w_in[(size_t)k * NIN + DT_COL + j]); }
    {
        const f32x4* gr = (const f32x4*)F.mix_g + F.lane;
        f32x4 v[8], nv[8];
        int m = gw;
        if (m < M) {
            const f32x4* xr = (const f32x4*)(F.x + (size_t)m * D) + F.lane;
#pragma unroll
            for (int j = 0; j < 8; ++j) v[j] = xr[64 * j];
        }
        for (; m < M; m += NGW) {
            const int mn = m + NGW;
            if (mn < M) { const f32x4* xr = (const f32x4*)(F.x + (size_t)mn * D) + F.lane;
#pragma unroll
                for (int j = 0; j < 8; ++j) nv[j] = xr[64 * j]; }
            float s = 0.f;
#pragma unroll
            for (int j = 0; j < 8; ++j) s += (v[j][0] * v[j][0] + v[j][1] * v[j][1]) + (v[j][2] * v[j][2] + v[j][3] * v[j][3]);
            const float rstd = rsqrtf(wave_sum(s) * (1.f / D) + EPS);
            u32x2* o8 = (u32x2*)(XN + (size_t)m * D) + F.lane;
#pragma unroll
            for (int j = 0; j < 8; ++j) { const f32x4 g = gr[64 * j]; u32x2 w; w.x = pk2(v[j][0] * rstd * g[0], v[j][1] * rstd * g[1]); w.y = pk2(v[j][2] * rstd * g[2], v[j][3] * rstd * g[3]); o8[64 * j] = w; }
#pragma unroll
            for (int j = 0; j < 8; ++j) v[j] = nv[j];
        }
    }
}

struct TrItem { const float* W; bf16* WT; const float* gs; int ldw, K, k0, n0; };
DI TrItem p0b_decode(const Frame& F, int r) {
    constexpr int I_O = 32 * 64, I_U = 32 * 256;
    TrItem t;
    if (r < I_O) { t.W = F.w_out; t.WT = (bf16*)(F.ws + WS_WOUT); t.gs = nullptr; t.ldw = D; t.K = D; t.k0 = 64 * (r / 64); t.n0 = 32 * (r % 64); return t; } r -= I_O;
    if (r < I_U) { t.W = F.w_up; t.WT = (bf16*)(F.ws + WS_WUP); t.gs = F.mlp_g; t.ldw = FF; t.K = D; t.k0 = 64 * (r / 256); t.n0 = 32 * (r % 256); return t; } r -= I_U;
    t.W = F.w_down; t.WT = (bf16*)(F.ws + WS_WDN); t.gs = nullptr; t.ldw = D; t.K = FF; t.k0 = 64 * (r / 64); t.n0 = 32 * (r % 64); return t;
}
DI void p0b_load(const TrItem& t, int lane, float (&v)[32]) {
    const float* p = t.W + (size_t)(t.k0 + (lane >> 5)) * t.ldw + t.n0 + (lane & 31);
#pragma unroll
    for (int i = 0; i < 32; ++i) v[i] = __builtin_nontemporal_load(p + (size_t)(2 * i) * t.ldw);
}
DI void p0b_weights(Frame& F) {
    LAS float* scr = (LAS float*)(F.lds + F.wave * 16384);
    constexpr int NIT_ALL = 32 * 64 + 32 * 256 + 128 * 64, NIT_EARLY = 9216;
    const int lane = F.lane;
    int it, stride, NIT;
    if (F.G == 256) {
        if (F.blk < 144) return;
        it = (F.blk - 144) * 8 + F.wave; stride = 896; NIT = NIT_ALL;
    } else {
        const int nb = (F.G > 32) ? F.G - 32 : F.G, vb = (F.G > 32) ? F.blk - 32 : F.blk;
        if (vb < 0) return;
        it = vb * 8 + F.wave; stride = nb * 8; NIT = NIT_ALL;
    }
    if (it >= NIT) return;
    TrItem cur = p0b_decode(F, it);
    float v[32]; p0b_load(cur, lane, v);
    for (;;) {
        const int nx = it + stride; const bool more = nx < NIT;
        TrItem nxt = cur; float w[32];
        if (more) { nxt = p0b_decode(F, nx); p0b_load(nxt, lane, w); }
#pragma unroll
        for (int i = 0; i < 32; ++i) scr[(2 * i + (lane >> 5)) * 33 + (lane & 31)] = v[i];
        asm volatile("s_waitcnt lgkmcnt(0)" ::: "memory");
        const int c = lane & 7;
        float g8[8];
#pragma unroll
        for (int e = 0; e < 8; ++e) g8[e] = 1.f;
        if (cur.gs) { const f32x4 g0 = *(const f32x4*)(cur.gs + cur.k0 + 8 * c), g1 = *(const f32x4*)(cur.gs + cur.k0 + 8 * c + 4);
#pragma unroll
            for (int e = 0; e < 4; ++e) { g8[e] = g0[e]; g8[4 + e] = g1[e]; } }
#pragma unroll
        for (int j = 0; j < 4; ++j) { const int n = (lane >> 3) + 8 * j; const LAS float* sp = scr + (8 * c) * 33 + n;
            u32x4 o; o.x = pk2(sp[0 * 33] * g8[0], sp[1 * 33] * g8[1]); o.y = pk2(sp[2 * 33] * g8[2], sp[3 * 33] * g8[3]); o.z = pk2(sp[4 * 33] * g8[4], sp[5 * 33] * g8[5]); o.w = pk2(sp[6 * 33] * g8[6], sp[7 * 33] * g8[7]);
            *(u32x4*)(cur.WT + (size_t)(cur.n0 + n) * cur.K + cur.k0 + 8 * c) = o; }
        asm volatile("s_waitcnt lgkmcnt(0)" ::: "memory");
        if (!more) break;
        it = nx; cur = nxt;
#pragma unroll
        for (int i = 0; i < 32; ++i) v[i] = w[i];
    }
}

DI void dt_gemm(Frame& F) {
    const bf16* XN = (const bf16*)(F.ws + WS_XN); const bf16* Wdt_t = (const bf16*)(F.ws + WS_WDT); float* DT = (float*)(F.ws + WS_DT);
    const int skip = (F.G == 256) ? 144 : ((F.G > 32) ? 32 : 0);
    const int nb = F.G - skip, vb = F.blk - skip;
    if (vb < 0) return;
    LAS f32x4* part = (LAS f32x4*)F.lds;
    const int fr = F.lane & 15, fq = F.lane >> 4, rgl = F.wave >> 2, kp = F.wave & 3;
    for (int pair = vb; pair < M / 32; pair += nb) {
        const int rg = pair * 2 + rgl;
        const bf16* ap = XN + (size_t)(rg * 16 + fr) * D + kp * 512 + fq * 8; const bf16* bp = Wdt_t + (size_t)fr * D + kp * 512 + fq * 8;
        bf16x8 av[16], bv[16];
#pragma unroll
        for (int k = 0; k < 16; ++k) { av[k] = *(const bf16x8*)(ap + 32 * k); bv[k] = *(const bf16x8*)(bp + 32 * k); }
        f32x4 acc = {0.f, 0.f, 0.f, 0.f};
#pragma unroll
        for (int k = 0; k < 16; ++k) acc = __builtin_amdgcn_mfma_f32_16x16x32_bf16(av[k], bv[k], acc, 0, 0, 0);
        part[F.wave * 64 + F.lane] = acc;
        __syncthreads();
        if (kp == 0) { const f32x4 t = (part[(rgl * 4 + 0) * 64 + F.lane] + part[(rgl * 4 + 1) * 64 + F.lane]) + (part[(rgl * 4 + 2) * 64 + F.lane] + part[(rgl * 4 + 3) * 64 + F.lane]);
#pragma unroll
            for (int jj = 0; jj < 4; ++jj) DT[(size_t)(rg * 16 + fq * 4 + jj) * 16 + fr] = t[jj]; }
        __syncthreads();
    }
}


#define MFMA32(a, b, c) __builtin_amdgcn_mfma_f32_32x32x16_bf16((a), (b), (c), 0, 0, 0)
DI int crow(int i, int hi) { return (i & 3) + 8 * (i >> 2) + 4 * hi; }
DI bf16x8 pack8(const f32x16& x, int s) {
    u32x4 p; p.x = pk2(x[8 * s + 0], x[8 * s + 1]); p.y = pk2(x[8 * s + 2], x[8 * s + 3]); p.z = pk2(x[8 * s + 4], x[8 * s + 5]); p.w = pk2(x[8 * s + 6], x[8 * s + 7]);
    return __builtin_bit_cast(bf16x8, p);
}
typedef short v4i16_t __attribute__((ext_vector_type(4)));
DI v4i16_t tr4(const LAS bf16* p) { return __builtin_amdgcn_ds_read_tr16_b64_v4i16((LAS v4i16_t*)p); }
DI bf16x8 tr_frag(const LAS bf16* T, int P, int Ra, int Rb, int cbase, int lane) {
    const int q = (lane & 15) >> 2, p4 = lane & 3, blk = (lane >> 4) & 1, co = cbase + 16 * blk + 4 * p4;
    const v4i16_t lo = tr4(T + (Ra + q) * P + co), hi = tr4(T + (Rb + q) * P + co);
    return (bf16x8){lo[0], lo[1], lo[2], lo[3], hi[0], hi[1], hi[2], hi[3]};
}
constexpr int KS_PITCH = 72;
DI void attn_item(Frame& F, int item) {
    const bf16* proj = (const bf16*)(F.ws + WS_PROJ); bf16* Y = (bf16*)(F.ws + WS_Y);
    LAS bf16* Vs = (LAS bf16*)F.lds;
    LAS bf16* Ks = (LAS bf16*)(F.lds + 2 * 160 * KS_PITCH * 2);
    LAS float* red = (LAS float*)(F.lds + 4 * 160 * KS_PITCH * 2);
    const int b = item >> 6, l0 = (item & 63) * 32, t0 = b * SEQ + l0, tmin = b * SEQ;
    const int lane = F.lane, r32 = lane & 31, hi = lane >> 5, w = F.wave;
    bf16x8 qf[2][4];
#pragma unroll
    for (int hh = 0; hh < 2; ++hh)
#pragma unroll
        for (int s = 0; s < 4; ++s) qf[hh][s] = *(const bf16x8*)(proj + (size_t)(t0 + r32) * NPROJ + PQ + (2 * w + hh) * 64 + 16 * s + 8 * hi);
#pragma unroll
    for (int j = 0; j < 10; ++j) { const int rr = (j * 8 + w) * 8 + (lane >> 3), ch = lane & 7;
        const int tsel = rr / 320, rem = rr % 320, kvh = rem / 160, kk = rem % 160;
        int row = t0 - 128 + kk; if (row < tmin) row = tmin;
        const bf16x8 v = *(const bf16x8*)(proj + (size_t)row * NPROJ + (tsel ? PV : PK) + kvh * 64 + ch * 8);
        *(LAS bf16x8*)((tsel ? Vs : Ks) + (kvh * 160 + kk) * KS_PITCH + ch * 8) = v; }
    __syncthreads();
    const int kv = w >> 2;
    f32x16 o[2][2]; float ssq = 0.f;
#pragma unroll
    for (int hh = 0; hh < 2; ++hh) {
        const int hq = 2 * w + hh;
        f32x16 S[5];
#pragma unroll
        for (int tile = 0; tile < 5; ++tile) {
            const LAS bf16* kp = Ks + (kv * 160 + tile * 32 + r32) * KS_PITCH + 8 * hi;
            f32x16 a;
#pragma unroll
            for (int i = 0; i < 16; ++i) a[i] = 0.f;
#pragma unroll
            for (int s = 0; s < 4; ++s) { const bf16x8 kf = *(const LAS bf16x8*)(kp + 16 * s); a = MFMA32(kf, qf[hh][s], a); }
            S[tile] = a;
        }
        __builtin_amdgcn_sched_barrier(0);
        constexpr float SC2 = 0.125f * 1.4426950408889634f;
        const float sink = F.sinks[hq] * 1.4426950408889634f; float mx = sink;
#pragma unroll
        for (int tile = 0; tile < 5; ++tile) { const bool tv = (l0 + 32 * tile >= 128);
#pragma unroll
            for (int i = 0; i < 16; ++i) { bool valid;
                if (tile == 0) valid = tv && (crow(i, hi) > r32); else if (tile == 4) valid = (crow(i, hi) <= r32); else valid = tv;
                const float sv = valid ? S[tile][i] * SC2 : -INFINITY; S[tile][i] = sv; mx = fmaxf(mx, sv); } }
        mx = fmaxf(mx, __shfl_xor(mx, 32));
        float den = 0.f;
#pragma unroll
        for (int tile = 0; tile < 5; ++tile)
#pragma unroll
            for (int i = 0; i < 16; ++i) { const float p = __builtin_amdgcn_exp2f(S[tile][i] - mx); S[tile][i] = p; den += p; }
        den += __shfl_xor(den, 32); den += __builtin_amdgcn_exp2f(sink - mx);
        const float inv = 1.f / den;
        __builtin_amdgcn_sched_barrier(0);
        f32x16 oT[2];
#pragma unroll
        for (int dh = 0; dh < 2; ++dh)
#pragma unroll
            for (int i = 0; i < 16; ++i) oT[dh][i] = 0.f;
#pragma unroll
        for (int tile = 0; tile < 5; ++tile)
#pragma unroll
            for (int s2 = 0; s2 < 2; ++s2) { const bf16x8 pf = pack8(S[tile], s2);
#pragma unroll
                for (int dh = 0; dh < 2; ++dh) { const bf16x8 va = tr_frag(Vs + kv * 160 * KS_PITCH, KS_PITCH, tile * 32 + 16 * s2 + 4 * hi, tile * 32 + 16 * s2 + 4 * hi + 8, dh * 32, lane); oT[dh] = MFMA32(va, pf, oT[dh]); } }
#pragma unroll
        for (int dh = 0; dh < 2; ++dh)
#pragma unroll
            for (int i = 0; i < 16; ++i) { const float v = oT[dh][i] * inv; o[hh][dh][i] = v; ssq += v * v; }
        __builtin_amdgcn_sched_barrier(0);
    }
    ssq += __shfl_xor(ssq, 32);
    if (hi == 0) red[w * 32 + r32] = ssq;
    __syncthreads();
    float tot = 0.f;
#pragma unroll
    for (int ww = 0; ww < 8; ++ww) tot += red[ww * 32 + r32];
    const float rstd = rsqrtf(tot * (1.f / 1024.f) + EPS);
    LAS bf16* stg = (LAS bf16*)F.lds + w * (32 * 136);
#pragma unroll
    for (int hh = 0; hh < 2; ++hh)
#pragma unroll
        for (int dh = 0; dh < 2; ++dh)
#pragma unroll
            for (int i4 = 0; i4 < 4; ++i4) { const int cl = hh * 64 + dh * 32 + 8 * i4 + 4 * hi; const f32x4 g = *(const f32x4*)(F.att_g + w * 128 + cl);
                u32x2 wv; wv.x = pk2(o[hh][dh][4 * i4 + 0] * rstd * g[0], o[hh][dh][4 * i4 + 1] * rstd * g[1]); wv.y = pk2(o[hh][dh][4 * i4 + 2] * rstd * g[2], o[hh][dh][4 * i4 + 3] * rstd * g[3]);
                *(LAS u32x2*)(stg + r32 * 136 + cl) = wv; }
    asm volatile("s_waitcnt lgkmcnt(0)" ::: "memory");
#pragma unroll
    for (int it = 0; it < 8; ++it) { const int row = it * 4 + (lane >> 4), ch = lane & 15;
        const u32x4 v = *(const LAS u32x4*)(stg + row * 136 + ch * 8);
        *(u32x4*)(Y + (size_t)(t0 + row) * D + DINNER + w * 128 + ch * 8) = v; }
    __syncthreads();
}
constexpr int XPN = 272, BPN = 144;
constexpr int L_X = 0, L_B = 128 * XPN * 2, L_C = L_B + 128 * BPN * 2, L_TDT = L_C + 128 * BPN * 2, L_TACS = L_TDT + 2048, L_RED = L_TACS + 2048;
static_assert(L_RED + 2048 <= LDS_BYTES, "LDS map of the SSD items");
constexpr size_t WS_PREV = WS_MISC, WS_CD = WS_MISC + 16 * MiB;
DI void ssd_tables(Frame& F, int row0, int g, LAS float* tdt, LAS float* tacs) {
    const float* DT = (const float*)(F.ws + WS_DT);
    const int hh = F.wave >> 1, s = (F.wave & 1) * 64 + F.lane, h = g * 4 + hh;
    const float dtv = softplus_f(DT[(size_t)(row0 + s) * 16 + h] + F.dt_bias[h]);
    float v = dtv * (-__expf(F.A_log[h]));
#pragma unroll
    for (int o = 1; o < 64; o <<= 1) { const float u = __shfl_up(v, o); if (F.lane >= o) v += u; }
    tdt[hh * 128 + s] = dtv; if (!(F.wave & 1)) tacs[hh * 128 + s] = v;
    __syncthreads();
    if (F.wave & 1) tacs[hh * 128 + s] = v + tacs[hh * 128 + 63];
    __syncthreads();
}
struct ConvRegs { bf16x8 v[19]; float wk[4][8]; float bb[8]; };
template <bool STATE> DI void conv_issue(Frame& F, const bf16* proj, int row0, int l00, int g, ConvRegs& R) {
    const int ck = F.lane, seg = F.wave;
    int ch0;
    if (ck < 32) ch0 = g * 256 + ck * 8; else if (ck < 48) ch0 = DINNER + g * 128 + (ck - 32) * 8; else ch0 = DINNER + 512 + g * 128 + (ck - 48) * 8;
    const bf16* src = proj + (size_t)(row0 + seg * 16 - 3) * NPROJ + PXBC + ch0;
#pragma unroll
    for (int r = 0; r < 19; ++r) { if (l00 + seg * 16 - 3 + r >= 0) R.v[r] = *(const bf16x8*)(src + (size_t)r * NPROJ); else R.v[r] = (bf16x8){0, 0, 0, 0, 0, 0, 0, 0}; }
#pragma unroll
    for (int k = 0; k < 4; ++k) { const f32x4 w0 = *(const f32x4*)(F.conv_w + k * CONVD + ch0), w1 = *(const f32x4*)(F.conv_w + k * CONVD + ch0 + 4);
#pragma unroll
        for (int e = 0; e < 4; ++e) { R.wk[k][e] = w0[e]; R.wk[k][4 + e] = w1[e]; } }
    { const f32x4 b0 = *(const f32x4*)(F.conv_b + ch0), b1 = *(const f32x4*)(F.conv_b + ch0 + 4);
#pragma unroll
      for (int e = 0; e < 4; ++e) { R.bb[e] = b0[e]; R.bb[4 + e] = b1[e]; } }
}
template <bool STATE> DI void conv_compute(Frame& F, const ConvRegs& R, const LAS float* tdt, const LAS float* tacs) {
    const int ck = F.lane, seg = F.wave;
    if (STATE && ck >= 48) return;
    int pitch, ccol, loff;
    if (ck < 32) { pitch = XPN; ccol = ck * 8; loff = L_X; }
    else if (ck < 48) { pitch = BPN; ccol = (ck - 32) * 8; loff = L_B; }
    else { pitch = BPN; ccol = (ck - 48) * 8; loff = L_C; }
    LAS bf16* dst = (LAS bf16*)(F.lds + loff);
    const int hh = ck >> 3;
#pragma unroll
    for (int i = 0; i < 16; ++i) { const int sr = seg * 16 + i; float o[8];
#pragma unroll
        for (int e = 0; e < 8; ++e) { float a = R.bb[e];
#pragma unroll
            for (int k = 0; k < 4; ++k) a += R.wk[k][e] * bf2f((bf16)R.v[i + k][e]);
            o[e] = silu_f(a); }
        if (STATE && ck < 32) { const float sc = tdt[hh * 128 + sr] * __expf(tacs[hh * 128 + 127] - tacs[hh * 128 + sr]);
#pragma unroll
            for (int e = 0; e < 8; ++e) o[e] *= sc; }
        u32x4 wv; wv.x = pk2(o[0], o[1]); wv.y = pk2(o[2], o[3]); wv.z = pk2(o[4], o[5]); wv.w = pk2(o[6], o[7]);
        *(LAS u32x4*)(dst + sr * pitch + ccol) = wv; }
}
DI void ssd_front(Frame& F, int item, f32x16 (&yd)[2][2]) {
    const bf16* proj = (const bf16*)(F.ws + WS_PROJ); float* ST = F.out; float* CD = (float*)(F.ws + WS_CD);
    const LAS bf16* Xs = (const LAS bf16*)(F.lds + L_X); const LAS bf16* Bs = (const LAS bf16*)(F.lds + L_B); const LAS bf16* Cs = (const LAS bf16*)(F.lds + L_C);
    LAS float* tdt = (LAS float*)(F.lds + L_TDT); LAS float* tacs = (LAS float*)(F.lds + L_TACS); LAS float* tw = (LAS float*)(F.lds + L_RED);
    const int b = item >> 6, c = (item >> 2) & 15, g = item & 3, row0 = b * SEQ + c * 128, l00 = c * 128;
    const int lane = F.lane, r32 = lane & 31, hi = lane >> 5, w = F.wave;
    ConvRegs cr; conv_issue<false>(F, proj, row0, l00, g, cr);
    ssd_tables(F, row0, g, tdt, tacs);
    { const int t = F.tid; tw[t] = tdt[t] * __expf(tacs[(t & ~127) + 127] - tacs[t]); }
    conv_compute<false>(F, cr, tdt, tacs);
    __syncthreads();
    const int hh = w >> 1, h = g * 4 + hh;
    {
        const int pt = w & 1;
        f32x16 acc[4];
#pragma unroll
        for (int nt = 0; nt < 4; ++nt)
#pragma unroll
            for (int i = 0; i < 16; ++i) acc[nt][i] = 0.f;
#pragma unroll
        for (int ks = 0; ks < 8; ++ks) { const bf16x8 ax = tr_frag(Xs, XPN, 16 * ks + 8 * hi, 16 * ks + 8 * hi + 4, hh * 64 + pt * 32, lane);
            const f32x4 w0 = *(const LAS f32x4*)(tw + hh * 128 + 16 * ks + 8 * hi), w1 = *(const LAS f32x4*)(tw + hh * 128 + 16 * ks + 8 * hi + 4);
            u32x4 pa; pa.x = pk2(bf2f((bf16)ax[0]) * w0[0], bf2f((bf16)ax[1]) * w0[1]); pa.y = pk2(bf2f((bf16)ax[2]) * w0[2], bf2f((bf16)ax[3]) * w0[3]);
            pa.z = pk2(bf2f((bf16)ax[4]) * w1[0], bf2f((bf16)ax[5]) * w1[1]); pa.w = pk2(bf2f((bf16)ax[6]) * w1[2], bf2f((bf16)ax[7]) * w1[3]);
            const bf16x8 af = __builtin_bit_cast(bf16x8, pa);
#pragma unroll
            for (int nt = 0; nt < 4; ++nt) { const bf16x8 bfr = tr_frag(Bs, BPN, 16 * ks + 8 * hi, 16 * ks + 8 * hi + 4, nt * 32, lane); acc[nt] = MFMA32(af, bfr, acc[nt]); } }
        float* stp = ST + (size_t)((b * 16 + c) * 16 + h) * 8192;
#pragma unroll
        for (int nt = 0; nt < 4; ++nt)
#pragma unroll
            for (int i = 0; i < 16; ++i) stp[(pt * 32 + crow(i, hi)) * 128 + nt * 32 + r32] = acc[nt][i];
        if (F.tid < 4) CD[(b * 16 + c) * 16 + g * 4 + F.tid] = __expf(tacs[F.tid * 128 + 127]);
    }
    const int pr = w & 1;
#pragma unroll
    for (int li = 0; li < 2; ++li) {
        const int lt = (li == 0) ? pr : 3 - pr, l = lt * 32 + r32;
        bf16x8 cf[8];
#pragma unroll
        for (int ks = 0; ks < 8; ++ks) cf[ks] = *(const LAS bf16x8*)(Cs + l * BPN + 16 * ks + 8 * hi);
        f32x16 acc[2];
#pragma unroll
        for (int pt = 0; pt < 2; ++pt)
#pragma unroll
            for (int i = 0; i < 16; ++i) acc[pt][i] = 0.f;
        const float al = tacs[hh * 128 + l];
#pragma unroll 1
        for (int st = 0; st <= lt; ++st) {
            f32x16 gT;
#pragma unroll
            for (int i = 0; i < 16; ++i) gT[i] = 0.f;
#pragma unroll
            for (int ks = 0; ks < 8; ++ks) { const bf16x8 bfr = *(const LAS bf16x8*)(Bs + (st * 32 + r32) * BPN + 16 * ks + 8 * hi); gT = MFMA32(bfr, cf[ks], gT); }
#pragma unroll
            for (int i = 0; i < 16; ++i) { const int s = st * 32 + crow(i, hi); const float v = gT[i] * __expf(al - tacs[hh * 128 + s]) * tdt[hh * 128 + s]; gT[i] = (s > l) ? 0.f : v; }
#pragma unroll
            for (int s2 = 0; s2 < 2; ++s2) { const bf16x8 mf = pack8(gT, s2);
#pragma unroll
                for (int pt = 0; pt < 2; ++pt) { const bf16x8 xa = tr_frag(Xs, XPN, st * 32 + 16 * s2 + 4 * hi, st * 32 + 16 * s2 + 4 * hi + 8, hh * 64 + pt * 32, lane); acc[pt] = MFMA32(xa, mf, acc[pt]); } }
        }
        yd[li][0] = acc[0]; yd[li][1] = acc[1];
        __builtin_amdgcn_sched_barrier(0);
    }
}
DI void ssd_scan(Frame& F) {
    const float* ST = F.out; const float* CD = (const float*)(F.ws + WS_CD); bf16* PREV = (bf16*)(F.ws + WS_PREV);
    for (int idx = F.blk * 512 + F.tid; idx < NBATCH * NH * 64 * 32; idx += F.G * 512) {
        const int n4 = idx & 31, p = (idx >> 5) & 63, h = (idx >> 11) & 15, b = idx >> 15;
        const size_t base0 = (size_t)(b * 256 + h) * 8192 + p * 128 + n4 * 4;
        f32x4 sv[15]; float d[15];
#pragma unroll
        for (int c = 0; c < 15; ++c) { sv[c] = *(const f32x4*)(ST + base0 + (size_t)c * 16 * 8192); d[c] = CD[(b * 16 + c) * 16 + h]; }
        f32x4 st = {0.f, 0.f, 0.f, 0.f};
#pragma unroll
        for (int c = 0; c < 16; ++c) { u32x2 wv; wv.x = pk2(st[0], st[1]); wv.y = pk2(st[2], st[3]); *(u32x2*)(PREV + base0 + (size_t)c * 16 * 8192) = wv;
            if (c < 15) st = st * d[c] + sv[c]; }
    }
}
DI void ssd_back(Frame& F, int item, f32x16 (&yd)[2][2]) {
    const bf16* proj = (const bf16*)(F.ws + WS_PROJ); bf16* Y = (bf16*)(F.ws + WS_Y); const bf16* PREV = (const bf16*)(F.ws + WS_PREV);
    const LAS bf16* Xs = (const LAS bf16*)(F.lds + L_X); const LAS bf16* Cs = (const LAS bf16*)(F.lds + L_C);
    LAS float* tacs = (LAS float*)(F.lds + L_TACS); LAS float* red = (LAS float*)(F.lds + L_RED);
    const int b = item >> 6, c = (item >> 2) & 15, g = item & 3, row0 = b * SEQ + c * 128;
    const int lane = F.lane, r32 = lane & 31, hi = lane >> 5, w = F.wave;
    const int hh = w >> 1, pr = w & 1, h = g * 4 + hh;
    const bf16* prevp = PREV + (size_t)((b * 16 + c) * 16 + h) * 8192;
    const float Dk = F.D_skip[h];
    bf16x8 pf[2][8];
#pragma unroll
    for (int ks = 0; ks < 8; ++ks)
#pragma unroll
        for (int pt = 0; pt < 2; ++pt) pf[pt][ks] = *(const bf16x8*)(prevp + (pt * 32 + r32) * 128 + 16 * ks + 8 * hi);
#pragma unroll
    for (int li = 0; li < 2; ++li) {
        const int lt = (li == 0) ? pr : 3 - pr, l = lt * 32 + r32;
        u32x2 zz[2][4];
#pragma unroll
        for (int pt = 0; pt < 2; ++pt)
#pragma unroll
            for (int i4 = 0; i4 < 4; ++i4) zz[pt][i4] = *(const u32x2*)(proj + (size_t)(row0 + l) * NPROJ + PZ + h * 64 + pt * 32 + 8 * i4 + 4 * hi);
        f32x16 acc[2];
#pragma unroll
        for (int pt = 0; pt < 2; ++pt)
#pragma unroll
            for (int i = 0; i < 16; ++i) acc[pt][i] = 0.f;
#pragma unroll
        for (int ks = 0; ks < 8; ++ks) { const bf16x8 cfk = *(const LAS bf16x8*)(Cs + l * BPN + 16 * ks + 8 * hi);
#pragma unroll
            for (int pt = 0; pt < 2; ++pt) acc[pt] = MFMA32(pf[pt][ks], cfk, acc[pt]); }
        const float el = __expf(tacs[hh * 128 + l]);
        float ss = 0.f;
#pragma unroll
        for (int pt = 0; pt < 2; ++pt)
#pragma unroll
            for (int i4 = 0; i4 < 4; ++i4) { const int p0 = pt * 32 + 8 * i4 + 4 * hi;
                const u32x2 xx = *(const LAS u32x2*)(Xs + l * XPN + hh * 64 + p0);
                const float z[4] = {__uint_as_float(zz[pt][i4].x << 16), __uint_as_float(zz[pt][i4].x & 0xffff0000u), __uint_as_float(zz[pt][i4].y << 16), __uint_as_float(zz[pt][i4].y & 0xffff0000u)};
                const float xv[4] = {__uint_as_float(xx.x << 16), __uint_as_float(xx.x & 0xffff0000u), __uint_as_float(xx.y << 16), __uint_as_float(xx.y & 0xffff0000u)};
#pragma unroll
                for (int e = 0; e < 4; ++e) { const float y = (yd[li][pt][4 * i4 + e] + el * acc[pt][4 * i4 + e] + Dk * xv[e]) * silu_f(z[e]); yd[li][pt][4 * i4 + e] = y; ss += y * y; } }
        ss += __shfl_xor(ss, 32);
        if (hi == 0) red[hh * 128 + l] = ss;
        __builtin_amdgcn_sched_barrier(0);
    }
    __syncthreads();
    LAS bf16* stg = (LAS bf16*)F.lds + w * (64 * 72);
#pragma unroll
    for (int li = 0; li < 2; ++li) {
        const int lt = (li == 0) ? pr : 3 - pr, l = lt * 32 + r32;
        const float rstd = rsqrtf(((red[l] + red[128 + l]) + (red[256 + l] + red[384 + l])) * (1.f / 256.f) + EPS);
#pragma unroll
        for (int pt = 0; pt < 2; ++pt)
#pragma unroll
            for (int i4 = 0; i4 < 4; ++i4) { const int cl = pt * 32 + 8 * i4 + 4 * hi; const f32x4 gg = *(const f32x4*)(F.ssm_g + h * 64 + cl);
                u32x2 wv; wv.x = pk2(yd[li][pt][4 * i4 + 0] * rstd * gg[0], yd[li][pt][4 * i4 + 1] * rstd * gg[1]); wv.y = pk2(yd[li][pt][4 * i4 + 2] * rstd * gg[2], yd[li][pt][4 * i4 + 3] * rstd * gg[3]);
                *(LAS u32x2*)(stg + (li * 32 + r32) * 72 + cl) = wv; }
    }
    asm volatile("s_waitcnt lgkmcnt(0)" ::: "memory");
#pragma unroll
    for (int it = 0; it < 8; ++it) { const int row = it * 8 + (lane >> 3), ch = lane & 7;
        const int lt = (row < 32) ? pr : 3 - pr, l = lt * 32 + (row & 31);
        const u32x4 v = *(const LAS u32x4*)(stg + row * 72 + ch * 8);
        *(u32x4*)(Y + (size_t)(row0 + l) * D + h * 64 + ch * 8) = v; }
    __syncthreads();
}

#define XB_TMO      128
#define XB_XCNT(j)  (256  + 64 * (j))
#define XB_XSUB(j)  (1280 + 64 * (j))
#define XB_XGEN(j)  (2304 + 64 * (j))
#define XB_TOP      3328
#define XB_TOPGEN   3392
#define XCD_BAR_WORDS 3456
#define XB_SPIN_CAP (1u << 18)
DI unsigned xb_ld(unsigned* p)              { return __hip_atomic_load(p, __ATOMIC_RELAXED, __HIP_MEMORY_SCOPE_AGENT); }
DI unsigned xb_add(unsigned* p, unsigned v) { return __hip_atomic_fetch_add(p, v, __ATOMIC_RELAXED, __HIP_MEMORY_SCOPE_AGENT); }
DI unsigned xb_xcc_id() { return (unsigned)__builtin_amdgcn_s_getreg((3 << 11) | 20) & 0xFu; }
#define XB_SPIN(cond, bar) do { unsigned _sp = 0; while (cond) { __builtin_amdgcn_s_sleep(1); \
    if ((++_sp & 255u) == 0u) { if (xb_ld(&(bar)[XB_TMO])) break; if (_sp > XB_SPIN_CAP) { atomicAdd(&(bar)[XB_TMO], 1u); break; } } } } while (0)
struct XcdBarrier { unsigned* bar; unsigned x; volatile LAS unsigned* st; };
DI XcdBarrier xcd_barrier_post(unsigned* bar, volatile LAS unsigned* st) {
    XcdBarrier b; b.bar = bar; b.x = xb_xcc_id(); b.st = st;
    if (threadIdx.x == 0) (void)xb_add(&bar[XB_XCNT(b.x)], 1u);
    return b;
}
DI void xcd_barrier_complete(unsigned* bar, unsigned x, unsigned& nloc, unsigned& nx) {
    const unsigned G = gridDim.x * gridDim.y * gridDim.z;
    unsigned sum, cnt, mine, sp = 0u;
    for (;;) {
        sum = 0u; cnt = 0u; mine = 0u;
#pragma unroll
        for (unsigned j = 0; j < 16; ++j) { const unsigned c = xb_ld(&bar[XB_XCNT(j)]); sum += c; cnt += (c > 0u) ? 1u : 0u; mine = (j == x) ? c : mine; }
        if (sum == G) break;
        __builtin_amdgcn_s_sleep(1);
        if ((++sp & 255u) == 0u) { if (xb_ld(&bar[XB_TMO])) break; if (sp > XB_SPIN_CAP) { atomicAdd(&bar[XB_TMO], 1u); break; } }
    }
    nloc = mine > 0u ? mine : 1u; nx = cnt > 0u ? cnt : 1u;
}
DI void xcd_barrier(const XcdBarrier& b) {
    asm volatile("s_waitcnt vmcnt(0)" ::: "memory");
    __syncthreads();
    if (threadIdx.x == 0) {
        unsigned* bar = b.bar;
        __builtin_amdgcn_s_waitcnt(0);
        unsigned nloc = b.st[0], nx = b.st[1];
        if (nloc == 0u) { xcd_barrier_complete(bar, b.x, nloc, nx); b.st[0] = nloc; b.st[1] = nx; }
        const unsigned old = xb_add(&bar[XB_XSUB(b.x)], 1u);
        const unsigned gen = old / nloc;
        if (old + 1u == (gen + 1u) * nloc) {
            __builtin_amdgcn_fence(__ATOMIC_RELEASE, "agent");
            asm volatile("s_waitcnt vmcnt(0)" ::: "memory");
            const unsigned og = xb_add(&bar[XB_TOP], 1u);
            const unsigned tg = og / nx;
            if (og + 1u == (tg + 1u) * nx) xb_add(&bar[XB_TOPGEN], 1u);
            else XB_SPIN(xb_ld(&bar[XB_TOPGEN]) == tg, bar);
            __builtin_amdgcn_fence(__ATOMIC_ACQUIRE, "agent");
            xb_add(&bar[XB_XGEN(b.x)], 1u);
            asm volatile("s_waitcnt vmcnt(0)" ::: "memory");
        } else {
            XB_SPIN(xb_ld(&bar[XB_XGEN(b.x)]) == gen, bar);
            __builtin_amdgcn_fence(__ATOMIC_ACQUIRE, "agent");
            asm volatile("s_waitcnt vmcnt(0)" ::: "memory");
        }
    }
    __syncthreads();
}

__global__ void __launch_bounds__(512, 2) mk_fwd(Args args) {
    extern __shared__ __attribute__((aligned(16))) unsigned char lds_raw[];
    Frame F;
    F.lds = (LAS unsigned char*)lds_raw;
    F.tid = threadIdx.x; F.lane = F.tid & 63; F.wave = __builtin_amdgcn_readfirstlane(F.tid >> 6); F.G = gridDim.x; F.blk = blockIdx.x;
    F.x = args.in[0]; F.mix_g = args.in[1]; F.w_in = args.in[2]; F.conv_w = args.in[3]; F.conv_b = args.in[4]; F.dt_bias = args.in[5]; F.A_log = args.in[6]; F.D_skip = args.in[7];
    F.ssm_g = args.in[8]; F.sinks = args.in[9]; F.att_g = args.in[10]; F.w_out = args.in[11]; F.mlp_g = args.in[12]; F.w_up = args.in[13]; F.w_down = args.in[14]; F.fin_g = args.in[15];
    F.out = args.out; F.ws = args.ws;
    bf16* XN = (bf16*)(F.ws + WS_XN); bf16* PROJ = (bf16*)(F.ws + WS_PROJ); bf16* Y = (bf16*)(F.ws + WS_Y); bf16* H = (bf16*)(F.ws + WS_H);
    float* SSQ1 = (float*)(F.ws + WS_SSQ1); float* SSQ2 = (float*)(F.ws + WS_SSQ2);
    if (F.tid < 16) ((LAS unsigned*)(F.lds + MISC_OFF))[F.tid] = 0u;
    __syncthreads();
    const XcdBarrier xbar = xcd_barrier_post((unsigned*)F.ws, (volatile LAS unsigned*)(F.lds + MISC_OFF));
    f32x16 yd[2][2];
#pragma unroll
    for (int a_ = 0; a_ < 2; ++a_)
#pragma unroll
        for (int b_ = 0; b_ < 2; ++b_)
#pragma unroll
            for (int i_ = 0; i_ < 16; ++i_) yd[a_][b_][i_] = 0.f;
    const int lo = args.ph_lo, hi = args.ph_hi;
    if (hi > 1000) cg::this_grid().sync();
#define IN(k) (lo <= (k) && (k) < hi)
#define SEAM(k) do { if (IN(k) && IN((k) + 1)) { xcd_barrier(xbar); } } while (0)
#define PH0() if (IN(0)) { p0_prologue(F); } SEAM(0);
#define PH1() if (IN(1)) { \
        pg8::Gemm g{XN, (const bf16*)(F.ws + WS_WIN), M, NPROJ, D}; pg8::StaticOrder S; S.init(M, NPROJ, F.G, F.blk); S.rebal = (F.G == 256) ? 1 : 0; \
        pg8::Epi<0> E{PROJ, NPROJ, nullptr, nullptr, nullptr, nullptr, nullptr}; \
        pg8::gemm_phase(F.lds, g, S, E); \
        dt_gemm(F); p0b_weights(F); } SEAM(1);
#define PH2() if (IN(2)) { if (F.blk < 256) { attn_item(F, F.blk); if (MK_PROBE_PHASE == 21) attn_item(F, F.blk); ssd_front(F, F.blk, yd); } } SEAM(2); \
    if (MK_PROBE_PHASE == 30) { for (int q_ = 0; q_ < 10; ++q_) xcd_barrier(xbar); } \
    if (IN(3)) { ssd_scan(F); } SEAM(3); \
    if (IN(4)) { if (F.blk < 256) ssd_back(F, F.blk, yd); } SEAM(4);
#define PH5() if (IN(5)) { \
        pg8::Gemm g{Y, (const bf16*)(F.ws + WS_WOUT), M, D, D}; pg8::StaticOrder S; S.init(M, D, F.G, F.blk); \
        pg8::Epi<1> E{XN, D, F.x, nullptr, SSQ1, nullptr, nullptr}; \
        pg8::gemm_phase(F.lds, g, S, E); } SEAM(5);
#define PH6() if (IN(6)) { \
        pg8::Gemm g{XN, (const bf16*)(F.ws + WS_WUP), M, FF, D}; pg8::StaticOrder S; S.init(M, FF, F.G, F.blk); \
        pg8::Epi<2> E{H, FF, nullptr, nullptr, nullptr, SSQ1, nullptr}; \
        pg8::gemm_phase(F.lds, g, S, E); } SEAM(6);
    PH0();
#if MK_PROBE_PHASE == 0
    PH0();
#endif
    PH1();
#if MK_PROBE_PHASE == 1
    PH1();
#endif
    PH2();
#if MK_PROBE_PHASE == 2
    PH2();
#endif
    PH5();
#if MK_PROBE_PHASE == 5
    PH5();
#endif
    PH6();
#if MK_PROBE_PHASE == 6
    PH6();
#endif
#define PH7() if (IN(7)) { \
        pg8::Gemm g{H, (const bf16*)(F.ws + WS_WDN), M, D, FF}; pg8::StaticOrder S; S.init(M, D, F.G, F.blk); \
        pg8::Epi<3> E{XN, D, F.fin_g, F.out, SSQ2, nullptr, (unsigned*)F.ws + 4096}; \
        pg8::gemm_phase(F.lds, g, S, E); }
    PH7();
#if MK_PROBE_PHASE == 7
    xcd_barrier(xbar);
    PH7();
#endif
}


extern "C" void kernel_launch(void* const* d_in, const int* in_sizes, int n_in, void* d_out, int out_size, void* d_ws, size_t ws_size, hipStream_t stream) {
    static int grid = 0;
    if (grid == 0) {
        int dev = 0, cus = 0, per_cu = 0;
        (void)hipGetDevice(&dev); (void)hipDeviceGetAttribute(&cus, hipDeviceAttributeMultiprocessorCount, dev);
        if (hipFuncSetAttribute((const void*)mk_fwd, hipFuncAttributeMaxDynamicSharedMemorySize, LDS_BYTES) != hipSuccess) { fprintf(stderr, "hipFuncSetAttribute failed\n"); }
        if (hipOccupancyMaxActiveBlocksPerMultiprocessor(&per_cu, (const void*)mk_fwd, 512, LDS_BYTES) != hipSuccess || per_cu < 1) per_cu = 1;
        (void)hipGetLastError();
        if (per_cu > 1) per_cu = 1;
        grid = cus * per_cu;
        if (grid <= 0) grid = 256;
        if (grid != 256) fprintf(stderr, "kernel_launch: grid %d != 256: the fused final norm needs one down-GEMM unit per workgroup\n", grid);
    }
    Args a{};
    for (int i = 0; i < 16; ++i) a.in[i] = (const float*)d_in[i];
    a.out = (float*)d_out; a.ws = (unsigned char*)d_ws;
    a.ph_lo = 0; a.ph_hi = 9;
    (void)hipMemsetAsync(d_ws, 0, 32768, stream);
    void* kargs[] = {&a};
    hipError_t e = hipLaunchCooperativeKernel((const void*)mk_fwd, dim3(grid), dim3(512), kargs, LDS_BYTES, stream);
    if (e != hipSuccess) fprintf(stderr, "cooperative launch failed: %s (grid %d)\n", hipGetErrorString(e), grid);
}
```

```cpp
#include <hip/hip_runtime.h>
#include <hip/hip_cooperative_groups.h>
#include <cstdio>
#include <cstdint>
namespace cg = cooperative_groups;

#ifndef MK_PROBE_PHASE
#define MK_PROBE_PHASE -1
#endif

#define DI __device__ __forceinline__
#define LAS __attribute__((address_space(3)))
typedef unsigned short bf16;
typedef short bf16x8 __attribute__((ext_vector_type(8)));
typedef float f32x4 __attribute__((ext_vector_type(4)));
typedef float f32x2 __attribute__((ext_vector_type(2)));
typedef unsigned u32x4 __attribute__((ext_vector_type(4)));
typedef unsigned u32x2 __attribute__((ext_vector_type(2)));
typedef float f32x16 __attribute__((ext_vector_type(16)));
typedef __bf16 bf16x2_t __attribute__((ext_vector_type(2)));

constexpr int M = 8192, D = 2048, SEQ = 2048, NBATCH = 4;
constexpr int NIN = 4368, NPROJ = 4352;
constexpr int PZ = 0, PXBC = 1024, PQ = 3072, PK = 4096, PV = 4224;
constexpr int DT_COL = 3072;
constexpr int NH = 16, HD = 64, NG = 4, NS = 128, DINNER = 1024, CONVD = 2048;
constexpr int FF = 8192;
constexpr float EPS = 1e-5f;

constexpr size_t MiB = 1u << 20;
constexpr size_t WS_WUP = 2 * MiB, WS_WDN = 34 * MiB, WS_XN = 66 * MiB;
constexpr size_t WS_SSQ1 = 98 * MiB, WS_SSQ2 = 98 * MiB + 256 * 1024, WS_DT = 98 * MiB + 512 * 1024;
constexpr size_t WS_H = 100 * MiB;
constexpr size_t WS_WIN = 100 * MiB, WS_WDT = 117 * MiB, WS_WOUT = 118 * MiB, WS_PROJ = 126 * MiB, WS_Y = 194 * MiB;
constexpr size_t WS_MISC = 228 * MiB;

constexpr int RING_BYTES = 131072, XLDS_OFF = RING_BYTES, LDS_BYTES = 149504 + 64, MISC_OFF = 149504;

DI float bf2f(bf16 v) { return __uint_as_float(((unsigned)v) << 16); }
DI unsigned f2bf(float f) { unsigned u = __float_as_uint(f); return (u + 0x7fffu + ((u >> 16) & 1u)) >> 16; }
DI unsigned pk2(float lo, float hi) { f32x2 v = {lo, hi}; bf16x2_t b = __builtin_convertvector(v, bf16x2_t); return __builtin_bit_cast(unsigned, b); }
DI float wave_sum(float v) {
#pragma unroll
    for (int o = 1; o < 64; o <<= 1) v += __shfl_xor(v, o);
    return v;
}
DI float silu_f(float x) { return x * __builtin_amdgcn_rcpf(1.f + __expf(-x)); }
DI float softplus_f(float x) { return x > 20.f ? x : log1pf(__expf(x)); }

namespace pg8 {
constexpr int BM = 256, BK = 64, HALF = 128, HTB = HALF * BK * 2, NXCD = 8, WGM = 8;
__host__ __device__ __forceinline__ int lds_byte(int r, int c) { const int st = (r >> 4) * 2 + (c >> 5), rr = r & 15, cc = c & 31, ob = rr * 64 + cc * 2; return st * 1024 + (ob ^ (((ob >> 9) & 1) << 5)); }
__host__ __device__ __forceinline__ void stage_rc(int b, int& R, int& C) { const int st = b / 1024, sb = b % 1024, swz = sb ^ (((sb >> 9) & 1) << 5); R = (st >> 1) * 16 + swz / 64; C = (st & 1) * 32 + (swz % 64) / 2; }
__host__ __device__ __forceinline__ int perm32(int rho) { const int n = rho >> 4, i = rho & 15; return 8 * (i >> 2) + 4 * n + (i & 3); }

struct Unit { int pm, pn; };
struct Gemm { const bf16* A; const bf16* Bt; int M, N, K; };
struct StaticOrder {
    int nM, nN, nwg, G, c;
    DI void init(int M_, int N_, int G_, int c_) { nM = M_ / BM; nN = N_ / BM; nwg = nM * nN; G = G_; c = c_; rebal = 0; }
    int rebal;
    DI bool next(int i, Unit& u) const {
        long L = (long)i * G + c;
        if (rebal) { if (i == 0) L = c; else if (i == 1) { if (c >= 144) return false; L = 256 + c; } else if (i == 2) { if (c >= 144) return false; L = 400 + c; } else return false; }
        if (L >= nwg) return false;
        int wgid = (int)L; { const int q = nwg / NXCD, r = nwg % NXCD, xcd = wgid % NXCD, off = wgid / NXCD; wgid = (xcd < r ? xcd * (q + 1) : r * (q + 1) + (xcd - r) * q) + off; }
        const int nig = WGM * nN, gid = wgid / nig, fm = gid * WGM, gsz = (nM - fm) < WGM ? (nM - fm) : WGM;
        u.pm = fm + ((wgid % nig) % gsz); u.pn = (wgid % nig) / gsz; return true;
    }
};

template <class Epi>
DI void gemm_phase(LAS unsigned char* lds, const Gemm g, const StaticOrder& S, const Epi& E) {
    const int tid = threadIdx.x, wid = __builtin_amdgcn_readfirstlane(tid >> 6), lane = tid & 63, wr = wid >> 2, wc = wid & 3, fr = lane & 15, fq = lane >> 4;
    const int K = g.K, nt = K / BK;
    unsigned voffA[2], voffB[2];
#pragma unroll
    for (int i = 0; i < 2; ++i) { int R, C; stage_rc(tid * 16 + i * 8192, R, C); const int Rb = (R & ~31) + perm32(R & 31);
        voffA[i] = (unsigned)(R * K + C) * 2u; voffB[i] = (unsigned)(Rb * K + C) * 2u; }
    const size_t kstep = (size_t)(BK * 2);
    const size_t hstep = (size_t)HALF * K * 2;
    const size_t tstep = 2 * hstep;
    const unsigned ldsw = (unsigned)wid * 1024u;
    const int aoff = lds_byte(wr * 64 + fr, fq * 8), boff = lds_byte(wc * 32 + fr, fq * 8);
#define PG8_SA(b, h) (((b) * 2 + (h)) * HTB)
#define PG8_SB(b, h) ((4 + (b) * 2 + (h)) * HTB)
#define PG8_STAGE(bufoff, gbase, voff) do { _Pragma("unroll") for (int _i = 0; _i < 2; ++_i) \
        __builtin_amdgcn_global_load_lds((const unsigned*)((const char*)(gbase) + (voff)[_i]), (LAS unsigned*)(lds + (bufoff) + ldsw + _i * 8192), 16, 0, 0); } while (0)
#define PG8_LDA(dst, b, h) do { _Pragma("unroll") for (int m = 0; m < 4; ++m) _Pragma("unroll") for (int k = 0; k < 2; ++k) dst[m][k] = *(const LAS bf16x8*)(lds + PG8_SA(b, h) + aoff + m * 2048 + k * 1024); } while (0)
#define PG8_LDB(dst, b, h) do { _Pragma("unroll") for (int n = 0; n < 2; ++n) _Pragma("unroll") for (int k = 0; k < 2; ++k) dst[n][k] = *(const LAS bf16x8*)(lds + PG8_SB(b, h) + boff + n * 2048 + k * 1024); } while (0)
#define PG8_MMA(ai, bj, At, Bt) do { __builtin_amdgcn_s_setprio(1); _Pragma("unroll") for (int m = 0; m < 4; ++m) _Pragma("unroll") for (int n = 0; n < 2; ++n) _Pragma("unroll") for (int k = 0; k < 2; ++k) \
        acc[ai][bj][m][n] = __builtin_amdgcn_mfma_f32_16x16x32_bf16(Bt[n][k], At[m][k], acc[ai][bj][m][n], 0, 0, 0); __builtin_amdgcn_s_setprio(0); } while (0)
#define PG8_WAIT_V(n) asm volatile("s_waitcnt vmcnt(" #n ")" ::: "memory")
#define PG8_WAIT_L(n) asm volatile("s_waitcnt lgkmcnt(" #n ")" ::: "memory")
#define PG8_BAR __builtin_amdgcn_s_barrier()
#define PG8_SCHED __builtin_amdgcn_sched_barrier(0)
    Unit cur, nxt; int ui = 0;
    if (!S.next(0, cur)) return;
    f32x4 acc[2][2][4][2];
#pragma unroll
    for (int a = 0; a < 2; ++a)
#pragma unroll
        for (int b = 0; b < 2; ++b)
#pragma unroll
            for (int m = 0; m < 4; ++m)
#pragma unroll
                for (int n = 0; n < 2; ++n) acc[a][b][m][n] = (f32x4){0.f, 0.f, 0.f, 0.f};
    bf16x8 At[4][2], B0[2][2], B1[2][2];
    const char* cA = (const char*)g.A + (size_t)cur.pm * tstep; const char* cB = (const char*)g.Bt + (size_t)cur.pn * tstep;
    PG8_STAGE(PG8_SB(0, 0), cB, voffB); PG8_STAGE(PG8_SB(0, 1), cB + hstep, voffB); PG8_STAGE(PG8_SA(0, 0), cA, voffA); PG8_STAGE(PG8_SA(0, 1), cA + hstep, voffA);
    if (wr == 1) PG8_BAR;
    PG8_WAIT_V(2); PG8_BAR;
    PG8_STAGE(PG8_SB(1, 0), cB + kstep, voffB); PG8_STAGE(PG8_SA(1, 0), cA + kstep, voffA); PG8_STAGE(PG8_SB(1, 1), cB + hstep + kstep, voffB);
    PG8_WAIT_V(6); PG8_BAR;
    for (;;) {
        const bool has_next = S.next(ui + 1, nxt);
        const char* nA = has_next ? (const char*)g.A + (size_t)nxt.pm * tstep : cA; const char* nB = has_next ? (const char*)g.Bt + (size_t)nxt.pn * tstep : cB;
        for (int t = 0; t < nt; t += 2) {
            const bool last = (t == nt - 2);
            const char* a1 = cA + (size_t)(t + 1) * kstep;
            const char* a2 = last ? nA : cA + (size_t)(t + 2) * kstep; const char* b2 = last ? nB : cB + (size_t)(t + 2) * kstep;
            const char* a3 = a2 + kstep; const char* b3 = b2 + kstep;
            PG8_LDB(B0, 0, 0); PG8_LDB(B1, 0, 1); PG8_SCHED; PG8_LDA(At, 0, 0); PG8_STAGE(PG8_SA(1, 1), a1 + hstep, voffA);
            PG8_WAIT_V(8); PG8_WAIT_L(0); PG8_BAR; PG8_MMA(0, 0, At, B0); PG8_MMA(0, 1, At, B1); PG8_BAR; PG8_SCHED;
            PG8_LDA(At, 0, 1); PG8_STAGE(PG8_SB(0, 0), b2, voffB); PG8_STAGE(PG8_SB(0, 1), b2 + hstep, voffB); PG8_STAGE(PG8_SA(0, 0), a2, voffA);
            PG8_WAIT_V(8); PG8_WAIT_L(0); PG8_BAR; PG8_MMA(1, 0, At, B0); PG8_MMA(1, 1, At, B1); PG8_BAR; PG8_SCHED;
            PG8_LDB(B0, 1, 0); PG8_LDB(B1, 1, 1); PG8_SCHED; PG8_LDA(At, 1, 0); PG8_STAGE(PG8_SA(0, 1), a2 + hstep, voffA);
            PG8_WAIT_V(8); PG8_WAIT_L(0); PG8_BAR; PG8_MMA(0, 0, At, B0); PG8_MMA(0, 1, At, B1); PG8_BAR; PG8_SCHED;
            PG8_LDA(At, 1, 1); PG8_STAGE(PG8_SB(1, 0), b3, voffB); PG8_STAGE(PG8_SB(1, 1), b3 + hstep, voffB); PG8_STAGE(PG8_SA(1, 0), a3, voffA);
            PG8_WAIT_V(8); PG8_WAIT_L(0); PG8_BAR; PG8_MMA(1, 0, At, B0); PG8_MMA(1, 1, At, B1); PG8_BAR; PG8_SCHED;
        }
        if (wr == 0) PG8_BAR;
        E(acc, cur, wr, wc, fr, fq, lds + XLDS_OFF);
        if (!has_next) break;
#pragma unroll
        for (int a = 0; a < 2; ++a)
#pragma unroll
            for (int b = 0; b < 2; ++b)
#pragma unroll
                for (int m = 0; m < 4; ++m)
#pragma unroll
                    for (int n = 0; n < 2; ++n) acc[a][b][m][n] = (f32x4){0.f, 0.f, 0.f, 0.f};
        cur = nxt; cA = nA; cB = nB; ++ui;
        if (wr == 1) PG8_BAR;
    }
    PG8_WAIT_V(0);
    PG8_BAR;
#undef PG8_SA
#undef PG8_SB
#undef PG8_STAGE
#undef PG8_LDA
#undef PG8_LDB
#undef PG8_MMA
#undef PG8_WAIT_V
#undef PG8_WAIT_L
#undef PG8_BAR
#undef PG8_SCHED
}

template <int MODE> struct Epi {
    bf16* O; int ldc; const float* base; float* outf; float* ssq; const float* ssq_in; unsigned* cnt;
    DI void operator()(f32x4 (&acc)[2][2][4][2], const Unit& u, int wr, int wc, int fr, int fq, LAS unsigned char* xl) const {
        const int row0 = u.pm * BM + wr * 64 + fr, col0 = u.pn * BM + wc * 32 + 8 * fq;
        if (MODE == 0) {
#pragma unroll
            for (int ai = 0; ai < 2; ++ai)
#pragma unroll
                for (int m = 0; m < 4; ++m) { bf16* rowp = O + (size_t)(row0 + ai * HALF + m * 16) * ldc + col0;
#pragma unroll
                    for (int bj = 0; bj < 2; ++bj) { const f32x4 v0 = acc[ai][bj][m][0], v1 = acc[ai][bj][m][1];
                        u32x4 w; w.x = pk2(v0[0], v0[1]); w.y = pk2(v0[2], v0[3]); w.z = pk2(v1[0], v1[1]); w.w = pk2(v1[2], v1[3]);
                        *(u32x4*)(rowp + bj * HALF) = w; } }
        } else if (MODE == 1) {
            LAS float* P = (LAS float*)xl;
#pragma unroll
            for (int ai = 0; ai < 2; ++ai)
#pragma unroll
                for (int m = 0; m < 4; ++m) { const int rl = ai * HALF + wr * 64 + m * 16 + fr; const size_t off = (size_t)(u.pm * BM + rl) * ldc + col0; float ss = 0.f;
#pragma unroll
                    for (int bj = 0; bj < 2; ++bj) {
                        const f32x4 x0 = __builtin_nontemporal_load((const f32x4*)(base + off + bj * HALF)), x1 = __builtin_nontemporal_load((const f32x4*)(base + off + bj * HALF + 4));
                        const f32x4 v0 = acc[ai][bj][m][0] + x0, v1 = acc[ai][bj][m][1] + x1;
                        if (outf) { *(f32x4*)(outf + off + bj * HALF) = v0; *(f32x4*)(outf + off + bj * HALF + 4) = v1; }
                        if (O) { u32x4 w; w.x = pk2(v0[0], v0[1]); w.y = pk2(v0[2], v0[3]); w.z = pk2(v1[0], v1[1]); w.w = pk2(v1[2], v1[3]); *(u32x4*)(O + off + bj * HALF) = w; }
                        ss += (v0[0] * v0[0] + v0[1] * v0[1]) + (v0[2] * v0[2] + v0[3] * v0[3]) + (v1[0] * v1[0] + v1[1] * v1[1]) + (v1[2] * v1[2] + v1[3] * v1[3]);
                    }
                    ss += __shfl_xor(ss, 16); ss += __shfl_xor(ss, 32);
                    if (fq == 0) P[rl * 4 + wc] = ss; }
            asm volatile("s_waitcnt lgkmcnt(0)" ::: "memory"); __builtin_amdgcn_s_barrier(); asm volatile("" ::: "memory");
            if (threadIdx.x < 256) { const int t = threadIdx.x; const float s = (P[t * 4 + 0] + P[t * 4 + 1]) + (P[t * 4 + 2] + P[t * 4 + 3]); ssq[(size_t)(u.pm * BM + t) * 8 + u.pn] = s; }
            asm volatile("s_waitcnt lgkmcnt(0)" ::: "memory"); __builtin_amdgcn_s_barrier(); asm volatile("" ::: "memory");
        } else if (MODE == 3) {
            LAS float* P = (LAS float*)xl; LAS float* R = (LAS float*)(xl + 4096);
#pragma unroll
            for (int ai = 0; ai < 2; ++ai)
#pragma unroll
                for (int m = 0; m < 4; ++m) { const int rl = ai * HALF + wr * 64 + m * 16 + fr; const size_t off = (size_t)(u.pm * BM + rl) * ldc + col0; float ss = 0.f;
#pragma unroll
                    for (int bj = 0; bj < 2; ++bj) { const u32x4 xb = __builtin_nontemporal_load((const u32x4*)(O + off + bj * HALF));
                        f32x4 v0 = acc[ai][bj][m][0], v1 = acc[ai][bj][m][1];
                        v0[0] += __uint_as_float(xb.x << 16); v0[1] += __uint_as_float(xb.x & 0xffff0000u); v0[2] += __uint_as_float(xb.y << 16); v0[3] += __uint_as_float(xb.y & 0xffff0000u);
                        v1[0] += __uint_as_float(xb.z << 16); v1[1] += __uint_as_float(xb.z & 0xffff0000u); v1[2] += __uint_as_float(xb.w << 16); v1[3] += __uint_as_float(xb.w & 0xffff0000u);
                        acc[ai][bj][m][0] = v0; acc[ai][bj][m][1] = v1;
                        ss += (v0[0] * v0[0] + v0[1] * v0[1]) + (v0[2] * v0[2] + v0[3] * v0[3]) + (v1[0] * v1[0] + v1[1] * v1[1]) + (v1[2] * v1[2] + v1[3] * v1[3]); }
                    ss += __shfl_xor(ss, 16); ss += __shfl_xor(ss, 32);
                    if (fq == 0) P[rl * 4 + wc] = ss; }
            asm volatile("s_waitcnt lgkmcnt(0)" ::: "memory"); __builtin_amdgcn_s_barrier(); asm volatile("" ::: "memory");
            const int t = threadIdx.x;
            if (t < 256) { const float sp = (P[t * 4 + 0] + P[t * 4 + 1]) + (P[t * 4 + 2] + P[t * 4 + 3]);
                __hip_atomic_store(ssq + (size_t)(u.pm * BM + t) * 8 + u.pn, sp, __ATOMIC_RELAXED, __HIP_MEMORY_SCOPE_AGENT); }
            asm volatile("s_waitcnt vmcnt(0)" ::: "memory"); __builtin_amdgcn_s_barrier(); asm volatile("" ::: "memory");
            if (t == 0) {
                __hip_atomic_fetch_add(cnt + 64 * u.pm, 1u, __ATOMIC_RELAXED, __HIP_MEMORY_SCOPE_AGENT);
                unsigned sp_ = 0;
                while (__hip_atomic_load(cnt + 64 * u.pm, __ATOMIC_RELAXED, __HIP_MEMORY_SCOPE_AGENT) < 8u) { __builtin_amdgcn_s_sleep(1); if (++sp_ > (1u << 22)) break; }
                __builtin_amdgcn_fence(__ATOMIC_ACQUIRE, "agent");
            }
            asm volatile("s_waitcnt vmcnt(0) lgkmcnt(0)" ::: "memory"); __builtin_amdgcn_s_barrier(); asm volatile("" ::: "memory");
            if (t < 256) { float tot = 0.f;
#pragma unroll
                for (int j = 0; j < 8; ++j) tot += __hip_atomic_load(ssq + (size_t)(u.pm * BM + t) * 8 + j, __ATOMIC_RELAXED, __HIP_MEMORY_SCOPE_AGENT);
                R[t] = rsqrtf(tot * (1.f / 2048.f) + EPS); }
            asm volatile("s_waitcnt vmcnt(0) lgkmcnt(0)" ::: "memory"); __builtin_amdgcn_s_barrier(); asm volatile("" ::: "memory");
            f32x4 gv[2][2];
#pragma unroll
            for (int bj = 0; bj < 2; ++bj) { gv[bj][0] = *(const f32x4*)(base + col0 + bj * HALF); gv[bj][1] = *(const f32x4*)(base + col0 + bj * HALF + 4); }
#pragma unroll
            for (int ai = 0; ai < 2; ++ai)
#pragma unroll
                for (int m = 0; m < 4; ++m) { const int rl = ai * HALF + wr * 64 + m * 16 + fr; const size_t off = (size_t)(u.pm * BM + rl) * ldc + col0; const float rstd = R[rl];
#pragma unroll
                    for (int bj = 0; bj < 2; ++bj) { *(f32x4*)(outf + off + bj * HALF) = acc[ai][bj][m][0] * rstd * gv[bj][0]; *(f32x4*)(outf + off + bj * HALF + 4) = acc[ai][bj][m][1] * rstd * gv[bj][1]; } }
        } else {
#pragma unroll
            for (int ai = 0; ai < 2; ++ai)
#pragma unroll
                for (int m = 0; m < 4; ++m) { const int row = row0 + ai * HALF + m * 16;
                    const f32x4 s0 = *(const f32x4*)(ssq_in + (size_t)row * 8), s1 = *(const f32x4*)(ssq_in + (size_t)row * 8 + 4);
                    const float rstd = rsqrtf(((s0[0] + s0[1]) + (s0[2] + s0[3]) + (s1[0] + s1[1]) + (s1[2] + s1[3])) * (1.f / 2048.f) + EPS);
                    bf16* rowp = O + (size_t)row * ldc + col0;
#pragma unroll
                    for (int bj = 0; bj < 2; ++bj) { f32x4 v0 = acc[ai][bj][m][0] * rstd, v1 = acc[ai][bj][m][1] * rstd;
#pragma unroll
                        for (int e = 0; e < 4; ++e) { const float a = fmaxf(v0[e], 0.f), b = fmaxf(v1[e], 0.f); v0[e] = a * a; v1[e] = b * b; }
                        u32x4 w; w.x = pk2(v0[0], v0[1]); w.y = pk2(v0[2], v0[3]); w.z = pk2(v1[0], v1[1]); w.w = pk2(v1[2], v1[3]);
                        *(u32x4*)(rowp + bj * HALF) = w; } }
        }
    }
};
}

struct Args { const float* in[16]; float* out; unsigned char* ws; int ph_lo, ph_hi; };

struct Frame {
    LAS unsigned char* lds; int tid, lane, wave, G, blk;
    const float *x, *mix_g, *w_in, *conv_w, *conv_b, *dt_bias, *A_log, *D_skip, *ssm_g, *sinks, *att_g, *w_out, *mlp_g, *w_up, *w_down, *fin_g;
    float* out; unsigned char* ws;
};

DI void p0_transpose_item(const float* W, int ldw, int src_col0, bf16* WT, int K, int dst_row0, const float* gs, LAS float* scr, int kb, int nb, int lane) {
    const int k0 = 64 * kb, n0 = 32 * nb;
    float v[32];
#pragma unroll
    for (int i = 0; i < 32; ++i) { const int kk = 2 * i + (lane >> 5); v[i] = __builtin_nontemporal_load(W + (size_t)(k0 + kk) * ldw + src_col0 + n0 + (lane & 31)); }
    if (gs) {
#pragma unroll
        for (int i = 0; i < 32; ++i) v[i] *= gs[k0 + 2 * i + (lane >> 5)]; }
#pragma unroll
    for (int i = 0; i < 32; ++i) scr[(2 * i + (lane >> 5)) * 33 + (lane & 31)] = v[i];
    asm volatile("s_waitcnt lgkmcnt(0)" ::: "memory");
    const int c = lane & 7;
#pragma unroll
    for (int j = 0; j < 4; ++j) { const int n = (lane >> 3) + 8 * j; const LAS float* s = scr + (8 * c) * 33 + n;
        u32x4 o; o.x = pk2(s[0 * 33], s[1 * 33]); o.y = pk2(s[2 * 33], s[3 * 33]); o.z = pk2(s[4 * 33], s[5 * 33]); o.w = pk2(s[6 * 33], s[7 * 33]);
        *(u32x4*)(WT + (size_t)(dst_row0 + n0 + n) * K + k0 + 8 * c) = o; }
    asm volatile("s_waitcnt lgkmcnt(0)" ::: "memory");
}
DI void p0_prologue(Frame& F) {
    LAS float* scr = (LAS float*)(F.lds + F.wave * 16384);
    const int gw = F.blk * 8 + F.wave, NGW = F.G * 8;
    bf16* Win_t = (bf16*)(F.ws + WS_WIN);
    bf16* Wdt_t = (bf16*)(F.ws + WS_WDT); bf16* XN = (bf16*)(F.ws + WS_XN);
    constexpr int I_A = 32 * 96, I_B = 32 * 40;
    constexpr int NITEMS = I_A + I_B;
    for (int it = gw; it < NITEMS; it += NGW) {
        int r = it;
        if (r < I_A) { p0_transpose_item(F.w_in, NIN, 0, Win_t, D, 0, nullptr, scr, r / 96, r % 96, F.lane); continue; } r -= I_A;
        p0_transpose_item(F.w_in, NIN, DT_COL + 16, Win_t, D, DT_COL, nullptr, scr, r / 40, r % 40, F.lane);
    }
    for (int i = F.blk * 512 + F.tid; i < 16 * D; i += F.G * 512) { const int j = i / D, k = i % D; Wdt_t[i] = (bf16)f2bf(F.w_in[(size_t)k * NIN + DT_COL + j]); }
    {
        const f32x4* gr = (const f32x4*)F.mix_g + F.lane;
        f32x4 v[8], nv[8];
        int m = gw;
        if (m < M) {
            const f32x4* xr = (const f32x4*)(F.x + (size_t)m * D) + F.lane;
#pragma unroll
            for (int j = 0; j < 8; ++j) v[j] = __builtin_nontemporal_load(xr + 64 * j);
        }
        for (; m < M; m += NGW) {
            const int mn = m + NGW;
            if (mn < M) { const f32x4* xr = (const f32x4*)(F.x + (size_t)mn * D) + F.lane;
#pragma unroll
                for (int j = 0; j < 8; ++j) nv[j] = __builtin_nontemporal_load(xr + 64 * j); }
            float s = 0.f;
#pragma unroll
            for (int j = 0; j < 8; ++j) s += (v[j][0] * v[j][0] + v[j][1] * v[j][1]) + (v[j][2] * v[j][2] + v[j][3] * v[j][3]);
            const float rstd = rsqrtf(wave_sum(s) * (1.f / D) + EPS);
            u32x2* o8 = (u32x2*)(XN + (size_t)m * D) + F.lane;
#pragma unroll
            for (int j = 0; j < 8; ++j) { const f32x4 g = gr[64 * j]; u32x2 w; w.x = pk2(v[j][0] * rstd * g[0], v[j][1] * rstd * g[1]); w.y = pk2(v[j][2] * rstd * g[2], v[j][3] * rstd * g[3]); o8[64 * j] = w; }
#pragma unroll
            for (int j = 0; j < 8; ++j) v[j] = nv[j];
        }
    }
}

struct TrItem { const float* W; bf16* WT; const float* gs; int ldw, K, k0, n0; };
DI TrItem p0b_decode(const Frame& F, int r) {
    constexpr int I_O = 32 * 64, I_U = 32 * 256;
    TrItem t;
    if (r < I_O) { t.W = F.w_out; t.WT = (bf16*)(F.ws + WS_WOUT); t.gs = nullptr; t.ldw = D; t.K = D; t.k0 = 64 * (r / 64); t.n0 = 32 * (r % 64); return t; } r -= I_O;
    if (r < I_U) { t.W = F.w_up; t.WT = (bf16*)(F.ws + WS_WUP); t.gs = F.mlp_g; t.ldw = FF; t.K = D; t.k0 = 64 * (r / 256); t.n0 = 32 * (r % 256); return t; } r -= I_U;
    t.W = F.w_down; t.WT = (bf16*)(F.ws + WS_WDN); t.gs = nullptr; t.ldw = D; t.K = FF; t.k0 = 64 * (r / 64); t.n0 = 32 * (r % 64); return t;
}
DI void p0b_load(const TrItem& t, int lane, float (&v)[32]) {
    const float* p = t.W + (size_t)(t.k0 + (lane >> 5)) * t.ldw + t.n0 + (lane & 31);
#pragma unroll
    for (int i = 0; i < 32; ++i) v[i] = __builtin_nontemporal_load(p + (size_t)(2 * i) * t.ldw);
}
DI void p0b_weights(Frame& F) {
    LAS float* scr = (LAS float*)(F.lds + F.wave * 16384);
    constexpr int NIT_ALL = 32 * 64 + 32 * 256 + 128 * 64, NIT_EARLY = 9216;
    const int lane = F.lane;
    int it, stride, NIT;
    if (F.G == 256) {
        if (F.blk < 144) return;
        it = (F.blk - 144) * 8 + F.wave; stride = 896; NIT = NIT_ALL;
    } else {
        const int nb = (F.G > 32) ? F.G - 32 : F.G, vb = (F.G > 32) ? F.blk - 32 : F.blk;
        if (vb < 0) return;
        it = vb * 8 + F.wave; stride = nb * 8; NIT = NIT_ALL;
    }
    if (it >= NIT) return;
    TrItem cur = p0b_decode(F, it);
    float v[32]; p0b_load(cur, lane, v);
    for (;;) {
        const int nx = it + stride; const bool more = nx < NIT;
        TrItem nxt = cur; float w[32];
        if (more) { nxt = p0b_decode(F, nx); p0b_load(nxt, lane, w); }
#pragma unroll
        for (int i = 0; i < 32; ++i) scr[(2 * i + (lane >> 5)) * 33 + (lane & 31)] = v[i];
        asm volatile("s_waitcnt lgkmcnt(0)" ::: "memory");
        const int c = lane & 7;
        float g8[8];
#pragma unroll
        for (int e = 0; e < 8; ++e) g8[e] = 1.f;
        if (cur.gs) { const f32x4 g0 = *(const f32x4*)(cur.gs + cur.k0 + 8 * c), g1 = *(const f32x4*)(cur.gs + cur.k0 + 8 * c + 4);
#pragma unroll
            for (int e = 0; e < 4; ++e) { g8[e] = g0[e]; g8[4 + e] = g1[e]; } }
#pragma unroll
        for (int j = 0; j < 4; ++j) { const int n = (lane >> 3) + 8 * j; const LAS float* sp = scr + (8 * c) * 33 + n;
            u32x4 o; o.x = pk2(sp[0 * 33] * g8[0], sp[1 * 33] * g8[1]); o.y = pk2(sp[2 * 33] * g8[2], sp[3 * 33] * g8[3]); o.z = pk2(sp[4 * 33] * g8[4], sp[5 * 33] * g8[5]); o.w = pk2(sp[6 * 33] * g8[6], sp[7 * 33] * g8[7]);
            *(u32x4*)(cur.WT + (size_t)(cur.n0 + n) * cur.K + cur.k0 + 8 * c) = o; }
        asm volatile("s_waitcnt lgkmcnt(0)" ::: "memory");
        if (!more) break;
        it = nx; cur = nxt;
#pragma unroll
        for (int i = 0; i < 32; ++i) v[i] = w[i];
    }
}

DI void dt_gemm(Frame& F) {
    const bf16* XN = (const bf16*)(F.ws + WS_XN); const bf16* Wdt_t = (const bf16*)(F.ws + WS_WDT); float* DT = (float*)(F.ws + WS_DT);
    const int skip = (F.G == 256) ? 144 : ((F.G > 32) ? 32 : 0);
    const int nb = F.G - skip, vb = F.blk - skip;
    if (vb < 0) return;
    LAS f32x4* part = (LAS f32x4*)F.lds;
    const int fr = F.lane & 15, fq = F.lane >> 4, rgl = F.wave >> 2, kp = F.wave & 3;
    for (int pair = vb; pair < M / 32; pair += nb) {
        const int rg = pair * 2 + rgl;
        const bf16* ap = XN + (size_t)(rg * 16 + fr) * D + kp * 512 + fq * 8; const bf16* bp = Wdt_t + (size_t)fr * D + kp * 512 + fq * 8;
        bf16x8 av[16], bv[16];
#pragma unroll
        for (int k = 0; k < 16; ++k) { av[k] = *(const bf16x8*)(ap + 32 * k); bv[k] = *(const bf16x8*)(bp + 32 * k); }
        f32x4 acc = {0.f, 0.f, 0.f, 0.f};
#pragma unroll
        for (int k = 0; k < 16; ++k) acc = __builtin_amdgcn_mfma_f32_16x16x32_bf16(av[k], bv[k], acc, 0, 0, 0);
        part[F.wave * 64 + F.lane] = acc;
        __syncthreads();
        if (kp == 0) { const f32x4 t = (part[(rgl * 4 + 0) * 64 + F.lane] + part[(rgl * 4 + 1) * 64 + F.lane]) + (part[(rgl * 4 + 2) * 64 + F.lane] + part[(rgl * 4 + 3) * 64 + F.lane]);
#pragma unroll
            for (int jj = 0; jj < 4; ++jj) DT[(size_t)(rg * 16 + fq * 4 + jj) * 16 + fr] = t[jj]; }
        __syncthreads();
    }
}


#define MFMA32(a, b, c) __builtin_amdgcn_mfma_f32_32x32x16_bf16((a), (b), (c), 0, 0, 0)
DI int crow(int i, int hi) { return (i & 3) + 8 * (i >> 2) + 4 * hi; }
DI bf16x8 pack8(const f32x16& x, int s) {
    u32x4 p; p.x = pk2(x[8 * s + 0], x[8 * s + 1]); p.y = pk2(x[8 * s + 2], x[8 * s + 3]); p.z = pk2(x[8 * s + 4], x[8 * s + 5]); p.w = pk2(x[8 * s + 6], x[8 * s + 7]);
    return __builtin_bit_cast(bf16x8, p);
}
typedef short v4i16_t __attribute__((ext_vector_type(4)));
DI v4i16_t tr4(const LAS bf16* p) { return __builtin_amdgcn_ds_read_tr16_b64_v4i16((LAS v4i16_t*)p); }
DI bf16x8 tr_frag(const LAS bf16* T, int P, int Ra, int Rb, int cbase, int lane) {
    const int q = (lane & 15) >> 2, p4 = lane & 3, blk = (lane >> 4) & 1, co = cbase + 16 * blk + 4 * p4;
    const v4i16_t lo = tr4(T + (Ra + q) * P + co), hi = tr4(T + (Rb + q) * P + co);
    return (bf16x8){lo[0], lo[1], lo[2], lo[3], hi[0], hi[1], hi[2], hi[3]};
}
constexpr int KS_PITCH = 72;
DI void attn_item(Frame& F, int item) {
    const bf16* proj = (const bf16*)(F.ws + WS_PROJ); bf16* Y = (bf16*)(F.ws + WS_Y);
    LAS bf16* Vs = (LAS bf16*)F.lds;
    LAS bf16* Ks = (LAS bf16*)(F.lds + 2 * 160 * KS_PITCH * 2);
    LAS float* red = (LAS float*)(F.lds + 4 * 160 * KS_PITCH * 2);
    const int b = item >> 6, l0 = (item & 63) * 32, t0 = b * SEQ + l0, tmin = b * SEQ;
    const int lane = F.lane, r32 = lane & 31, hi = lane >> 5, w = F.wave;
    bf16x8 qf[2][4];
#pragma unroll
    for (int hh = 0; hh < 2; ++hh)
#pragma unroll
        for (int s = 0; s < 4; ++s) qf[hh][s] = __builtin_nontemporal_load((const bf16x8*)(proj + (size_t)(t0 + r32) * NPROJ + PQ + (2 * w + hh) * 64 + 16 * s + 8 * hi));
#pragma unroll
    for (int j = 0; j < 10; ++j) { const int rr = (j * 8 + w) * 8 + (lane >> 3), ch = lane & 7;
        const int tsel = rr / 320, rem = rr % 320, kvh = rem / 160, kk = rem % 160;
        int row = t0 - 128 + kk; if (row < tmin) row = tmin;
        const bf16x8 v = *(const bf16x8*)(proj + (size_t)row * NPROJ + (tsel ? PV : PK) + kvh * 64 + ch * 8);
        *(LAS bf16x8*)((tsel ? Vs : Ks) + (kvh * 160 + kk) * KS_PITCH + ch * 8) = v; }
    __syncthreads();
    const int kv = w >> 2;
    f32x16 o[2][2]; float ssq = 0.f;
#pragma unroll
    for (int hh = 0; hh < 2; ++hh) {
        const int hq = 2 * w + hh;
        f32x16 S[5];
#pragma unroll
        for (int tile = 0; tile < 5; ++tile) {
            const LAS bf16* kp = Ks + (kv * 160 + tile * 32 + r32) * KS_PITCH + 8 * hi;
            f32x16 a;
#pragma unroll
            for (int i = 0; i < 16; ++i) a[i] = 0.f;
#pragma unroll
            for (int s = 0; s < 4; ++s) { const bf16x8 kf = *(const LAS bf16x8*)(kp + 16 * s); a = MFMA32(kf, qf[hh][s], a); }
            S[tile] = a;
        }
        __builtin_amdgcn_sched_barrier(0);
        constexpr float SC2 = 0.125f * 1.4426950408889634f;
        const float sink = F.sinks[hq] * 1.4426950408889634f; float mx = sink;
#pragma unroll
        for (int tile = 0; tile < 5; ++tile) { const bool tv = (l0 + 32 * tile >= 128);
#pragma unroll
            for (int i = 0; i < 16; ++i) { bool valid;
                if (tile == 0) valid = tv && (crow(i, hi) > r32); else if (tile == 4) valid = (crow(i, hi) <= r32); else valid = tv;
                const float sv = valid ? S[tile][i] * SC2 : -INFINITY; S[tile][i] = sv; mx = fmaxf(mx, sv); } }
        mx = fmaxf(mx, __shfl_xor(mx, 32));
        float den = 0.f;
#pragma unroll
        for (int tile = 0; tile < 5; ++tile)
#pragma unroll
            for (int i = 0; i < 16; ++i) { const float p = __builtin_amdgcn_exp2f(S[tile][i] - mx); S[tile][i] = p; den += p; }
        den += __shfl_xor(den, 32); den += __builtin_amdgcn_exp2f(sink - mx);
        const float inv = 1.f / den;
        __builtin_amdgcn_sched_barrier(0);
        f32x16 oT[2];
#pragma unroll
        for (int dh = 0; dh < 2; ++dh)
#pragma unroll
            for (int i = 0; i < 16; ++i) oT[dh][i] = 0.f;
#pragma unroll
        for (int tile = 0; tile < 5; ++tile)
#pragma unroll
            for (int s2 = 0; s2 < 2; ++s2) { const bf16x8 pf = pack8(S[tile], s2);
#pragma unroll
                for (int dh = 0; dh < 2; ++dh) { const bf16x8 va = tr_frag(Vs + kv * 160 * KS_PITCH, KS_PITCH, tile * 32 + 16 * s2 + 4 * hi, tile * 32 + 16 * s2 + 4 * hi + 8, dh * 32, lane); oT[dh] = MFMA32(va, pf, oT[dh]); } }
#pragma unroll
        for (int dh = 0; dh < 2; ++dh)
#pragma unroll
            for (int i = 0; i < 16; ++i) { const float v = oT[dh][i] * inv; o[hh][dh][i] = v; ssq += v * v; }
        __builtin_amdgcn_sched_barrier(0);
    }
    ssq += __shfl_xor(ssq, 32);
    if (hi == 0) red[w * 32 + r32] = ssq;
    __syncthreads();
    float tot = 0.f;
#pragma unroll
    for (int ww = 0; ww < 8; ++ww) tot += red[ww * 32 + r32];
    const float rstd = rsqrtf(tot * (1.f / 1024.f) + EPS);
    LAS bf16* stg = (LAS bf16*)F.lds + w * (32 * 136);
#pragma unroll
    for (int hh = 0; hh < 2; ++hh)
#pragma unroll
        for (int dh = 0; dh < 2; ++dh)
#pragma unroll
            for (int i4 = 0; i4 < 4; ++i4) { const int cl = hh * 64 + dh * 32 + 8 * i4 + 4 * hi; const f32x4 g = *(const f32x4*)(F.att_g + w * 128 + cl);
                u32x2 wv; wv.x = pk2(o[hh][dh][4 * i4 + 0] * rstd * g[0], o[hh][dh][4 * i4 + 1] * rstd * g[1]); wv.y = pk2(o[hh][dh][4 * i4 + 2] * rstd * g[2], o[hh][dh][4 * i4 + 3] * rstd * g[3]);
                *(LAS u32x2*)(stg + r32 * 136 + cl) = wv; }
    asm volatile("s_waitcnt lgkmcnt(0)" ::: "memory");
#pragma unroll
    for (int it = 0; it < 8; ++it) { const int row = it * 4 + (lane >> 4), ch = lane & 15;
        const u32x4 v = *(const LAS u32x4*)(stg + row * 136 + ch * 8);
        *(u32x4*)(Y + (size_t)(t0 + row) * D + DINNER + w * 128 + ch * 8) = v; }
    __syncthreads();
}
constexpr int XPN = 272, BPN = 144;
constexpr int L_X = 0, L_B = 128 * XPN * 2, L_C = L_B + 128 * BPN * 2, L_TDT = L_C + 128 * BPN * 2, L_TACS = L_TDT + 2048, L_RED = L_TACS + 2048;
static_assert(L_RED + 2048 <= LDS_BYTES, "LDS map of the SSD items");
constexpr size_t WS_PREV = WS_MISC, WS_CD = WS_MISC + 16 * MiB;
DI void ssd_tables(Frame& F, int row0, int g, LAS float* tdt, LAS float* tacs) {
    const float* DT = (const float*)(F.ws + WS_DT);
    const int hh = F.wave >> 1, s = (F.wave & 1) * 64 + F.lane, h = g * 4 + hh;
    const float dtv = softplus_f(DT[(size_t)(row0 + s) * 16 + h] + F.dt_bias[h]);
    float v = dtv * (-__expf(F.A_log[h]));
#pragma unroll
    for (int o = 1; o < 64; o <<= 1) { const float u = __shfl_up(v, o); if (F.lane >= o) v += u; }
    tdt[hh * 128 + s] = dtv; if (!(F.wave & 1)) tacs[hh * 128 + s] = v;
    __syncthreads();
    if (F.wave & 1) tacs[hh * 128 + s] = v + tacs[hh * 128 + 63];
    __syncthreads();
}
struct ConvRegs { bf16x8 v[19]; float wk[4][8]; float bb[8]; };
template <bool STATE> DI void conv_issue(Frame& F, const bf16* proj, int row0, int l00, int g, ConvRegs& R) {
    const int ck = F.lane, seg = F.wave;
    int ch0;
    if (ck < 32) ch0 = g * 256 + ck * 8; else if (ck < 48) ch0 = DINNER + g * 128 + (ck - 32) * 8; else ch0 = DINNER + 512 + g * 128 + (ck - 48) * 8;
    const bf16* src = proj + (size_t)(row0 + seg * 16 - 3) * NPROJ + PXBC + ch0;
#pragma unroll
    for (int r = 0; r < 19; ++r) { if (l00 + seg * 16 - 3 + r >= 0) R.v[r] = __builtin_nontemporal_load((const bf16x8*)(src + (size_t)r * NPROJ)); else R.v[r] = (bf16x8){0, 0, 0, 0, 0, 0, 0, 0}; }
#pragma unroll
    for (int k = 0; k < 4; ++k) { const f32x4 w0 = *(const f32x4*)(F.conv_w + k * CONVD + ch0), w1 = *(const f32x4*)(F.conv_w + k * CONVD + ch0 + 4);
#pragma unroll
        for (int e = 0; e < 4; ++e) { R.wk[k][e] = w0[e]; R.wk[k][4 + e] = w1[e]; } }
    { const f32x4 b0 = *(const f32x4*)(F.conv_b + ch0), b1 = *(const f32x4*)(F.conv_b + ch0 + 4);
#pragma unroll
      for (int e = 0; e < 4; ++e) { R.bb[e] = b0[e]; R.bb[4 + e] = b1[e]; } }
}
template <bool STATE> DI void conv_compute(Frame& F, const ConvRegs& R, const LAS float* tdt, const LAS float* tacs) {
    const int ck = F.lane, seg = F.wave;
    if (STATE && ck >= 48) return;
    int pitch, ccol, loff;
    if (ck < 32) { pitch = XPN; ccol = ck * 8; loff = L_X; }
    else if (ck < 48) { pitch = BPN; ccol = (ck - 32) * 8; loff = L_B; }
    else { pitch = BPN; ccol = (ck - 48) * 8; loff = L_C; }
    LAS bf16* dst = (LAS bf16*)(F.lds + loff);
    const int hh = ck >> 3;
#pragma unroll
    for (int i = 0; i < 16; ++i) { const int sr = seg * 16 + i; float o[8];
#pragma unroll
        for (int e = 0; e < 8; ++e) { float a = R.bb[e];
#pragma unroll
            for (int k = 0; k < 4; ++k) a += R.wk[k][e] * bf2f((bf16)R.v[i + k][e]);
            o[e] = silu_f(a); }
        if (STATE && ck < 32) { const float sc = tdt[hh * 128 + sr] * __expf(tacs[hh * 128 + 127] - tacs[hh * 128 + sr]);
#pragma unroll
            for (int e = 0; e < 8; ++e) o[e] *= sc; }
        u32x4 wv; wv.x = pk2(o[0], o[1]); wv.y = pk2(o[2], o[3]); wv.z = pk2(o[4], o[5]); wv.w = pk2(o[6], o[7]);
        *(LAS u32x4*)(dst + sr * pitch + ccol) = wv; }
}
DI void ssd_front(Frame& F, int item, f32x16 (&yd)[2][2]) {
    const bf16* proj = (const bf16*)(F.ws + WS_PROJ); float* ST = F.out; float* CD = (float*)(F.ws + WS_CD);
    const LAS bf16* Xs = (const LAS bf16*)(F.lds + L_X); const LAS bf16* Bs = (const LAS bf16*)(F.lds + L_B); const LAS bf16* Cs = (const LAS bf16*)(F.lds + L_C);
    LAS float* tdt = (LAS float*)(F.lds + L_TDT); LAS float* tacs = (LAS float*)(F.lds + L_TACS); LAS float* tw = (LAS float*)(F.lds + L_RED);
    const int b = item >> 6, c = (item >> 2) & 15, g = item & 3, row0 = b * SEQ + c * 128, l00 = c * 128;
    const int lane = F.lane, r32 = lane & 31, hi = lane >> 5, w = F.wave;
    ConvRegs cr; conv_issue<false>(F, proj, row0, l00, g, cr);
    ssd_tables(F, row0, g, tdt, tacs);
    { const int t = F.tid; tw[t] = tdt[t] * __expf(tacs[(t & ~127) + 127] - tacs[t]); }
    conv_compute<false>(F, cr, tdt, tacs);
    __syncthreads();
    const int hh = w >> 1, h = g * 4 + hh;
    {
        const int pt = w & 1;
        f32x16 acc[4];
#pragma unroll
        for (int nt = 0; nt < 4; ++nt)
#pragma unroll
            for (int i = 0; i < 16; ++i) acc[nt][i] = 0.f;
#pragma unroll
        for (int ks = 0; ks < 8; ++ks) { const bf16x8 ax = tr_frag(Xs, XPN, 16 * ks + 8 * hi, 16 * ks + 8 * hi + 4, hh * 64 + pt * 32, lane);
            const f32x4 w0 = *(const LAS f32x4*)(tw + hh * 128 + 16 * ks + 8 * hi), w1 = *(const LAS f32x4*)(tw + hh * 128 + 16 * ks + 8 * hi + 4);
            u32x4 pa; pa.x = pk2(bf2f((bf16)ax[0]) * w0[0], bf2f((bf16)ax[1]) * w0[1]); pa.y = pk2(bf2f((bf16)ax[2]) * w0[2], bf2f((bf16)ax[3]) * w0[3]);
            pa.z = pk2(bf2f((bf16)ax[4]) * w1[0], bf2f((bf16)ax[5]) * w1[1]); pa.w = pk2(bf2f((bf16)ax[6]) * w1[2], bf2f((bf16)ax[7]) * w1[3]);
            const bf16x8 af = __builtin_bit_cast(bf16x8, pa);
#pragma unroll
            for (int nt = 0; nt < 4; ++nt) { const bf16x8 bfr = tr_frag(Bs, BPN, 16 * ks + 8 * hi, 16 * ks + 8 * hi + 4, nt * 32, lane); acc[nt] = MFMA32(af, bfr, acc[nt]); } }
        float* stp = ST + (size_t)((b * 16 + c) * 16 + h) * 8192;
#pragma unroll
        for (int nt = 0; nt < 4; ++nt)
#pragma unroll
            for (int i = 0; i < 16; ++i) stp[(pt * 32 + crow(i, hi)) * 128 + nt * 32 + r32] = acc[nt][i];
        if (F.tid < 4) CD[(b * 16 + c) * 16 + g * 4 + F.tid] = __expf(tacs[F.tid * 128 + 127]);
    }
    const int pr = w & 1;
#pragma unroll
    for (int li = 0; li < 2; ++li) {
        const int lt = (li == 0) ? pr : 3 - pr, l = lt * 32 + r32;
        bf16x8 cf[8];
#pragma unroll
        for (int ks = 0; ks < 8; ++ks) cf[ks] = *(const LAS bf16x8*)(Cs + l * BPN + 16 * ks + 8 * hi);
        f32x16 acc[2];
#pragma unroll
        for (int pt = 0; pt < 2; ++pt)
#pragma unroll
            for (int i = 0; i < 16; ++i) acc[pt][i] = 0.f;
        const float al = tacs[hh * 128 + l];
#pragma unroll 1
        for (int st = 0; st <= lt; ++st) {
            f32x16 gT;
#pragma unroll
            for (int i = 0; i < 16; ++i) gT[i] = 0.f;
#pragma unroll
            for (int ks = 0; ks < 8; ++ks) { const bf16x8 bfr = *(const LAS bf16x8*)(Bs + (st * 32 + r32) * BPN + 16 * ks + 8 * hi); gT = MFMA32(bfr, cf[ks], gT); }
#pragma unroll
            for (int i = 0; i < 16; ++i) { const int s = st * 32 + crow(i, hi); const float v = gT[i] * __expf(al - tacs[hh * 128 + s]) * tdt[hh * 128 + s]; gT[i] = (s > l) ? 0.f : v; }
#pragma unroll
            for (int s2 = 0; s2 < 2; ++s2) { const bf16x8 mf = pack8(gT, s2);
#pragma unroll
                for (int pt = 0; pt < 2; ++pt) { const bf16x8 xa = tr_frag(Xs, XPN, st * 32 + 16 * s2 + 4 * hi, st * 32 + 16 * s2 + 4 * hi + 8, hh * 64 + pt * 32, lane); acc[pt] = MFMA32(xa, mf, acc[pt]); } }
        }
        yd[li][0] = acc[0]; yd[li][1] = acc[1];
        __builtin_amdgcn_sched_barrier(0);
    }
}
DI void ssd_scan(Frame& F) {
    const float* ST = F.out; const float* CD = (const float*)(F.ws + WS_CD); bf16* PREV = (bf16*)(F.ws + WS_PREV);
    for (int idx = F.blk * 512 + F.tid; idx < NBATCH * NH * 64 * 32; idx += F.G * 512) {
        const int n4 = idx & 31, p = (idx >> 5) & 63, h = (idx >> 11) & 15, b = idx >> 15;
        const size_t base0 = (size_t)(b * 256 + h) * 8192 + p * 128 + n4 * 4;
        f32x4 sv[15]; float d[15];
#pragma unroll
        for (int c = 0; c < 15; ++c) { sv[c] = __builtin_nontemporal_load((const f32x4*)(ST + base0 + (size_t)c * 16 * 8192)); d[c] = CD[(b * 16 + c) * 16 + h]; }
        f32x4 st = {0.f, 0.f, 0.f, 0.f};
#pragma unroll
        for (int c = 0; c < 16; ++c) { u32x2 wv; wv.x = pk2(st[0], st[1]); wv.y = pk2(st[2], st[3]); *(u32x2*)(PREV + base0 + (size_t)c * 16 * 8192) = wv;
            if (c < 15) st = st * d[c] + sv[c]; }
    }
}
DI void ssd_back(Frame& F, int item, f32x16 (&yd)[2][2]) {
    const bf16* proj = (const bf16*)(F.ws + WS_PROJ); bf16* Y = (bf16*)(F.ws + WS_Y); const bf16* PREV = (const bf16*)(F.ws + WS_PREV);
    const LAS bf16* Xs = (const LAS bf16*)(F.lds + L_X); const LAS bf16* Cs = (const LAS bf16*)(F.lds + L_C);
    LAS float* tacs = (LAS float*)(F.lds + L_TACS); LAS float* red = (LAS float*)(F.lds + L_RED);
    const int b = item >> 6, c = (item >> 2) & 15, g = item & 3, row0 = b * SEQ + c * 128;
    const int lane = F.lane, r32 = lane & 31, hi = lane >> 5, w = F.wave;
    const int hh = w >> 1, pr = w & 1, h = g * 4 + hh;
    const bf16* prevp = PREV + (size_t)((b * 16 + c) * 16 + h) * 8192;
    const float Dk = F.D_skip[h];
    bf16x8 pf[2][8];
#pragma unroll
    for (int ks = 0; ks < 8; ++ks)
#pragma unroll
        for (int pt = 0; pt < 2; ++pt) pf[pt][ks] = *(const bf16x8*)(prevp + (pt * 32 + r32) * 128 + 16 * ks + 8 * hi);
#pragma unroll
    for (int li = 0; li < 2; ++li) {
        const int lt = (li == 0) ? pr : 3 - pr, l = lt * 32 + r32;
        u32x2 zz[2][4];
#pragma unroll
        for (int pt = 0; pt < 2; ++pt)
#pragma unroll
            for (int i4 = 0; i4 < 4; ++i4) zz[pt][i4] = __builtin_nontemporal_load((const u32x2*)(proj + (size_t)(row0 + l) * NPROJ + PZ + h * 64 + pt * 32 + 8 * i4 + 4 * hi));
        f32x16 acc[2];
#pragma unroll
        for (int pt = 0; pt < 2; ++pt)
#pragma unroll
            for (int i = 0; i < 16; ++i) acc[pt][i] = 0.f;
#pragma unroll
        for (int ks = 0; ks < 8; ++ks) { const bf16x8 cfk = *(const LAS bf16x8*)(Cs + l * BPN + 16 * ks + 8 * hi);
#pragma unroll
            for (int pt = 0; pt < 2; ++pt) acc[pt] = MFMA32(pf[pt][ks], cfk, acc[pt]); }
        const float el = __expf(tacs[hh * 128 + l]);
        float ss = 0.f;
#pragma unroll
        for (int pt = 0; pt < 2; ++pt)
#pragma unroll
            for (int i4 = 0; i4 < 4; ++i4) { const int p0 = pt * 32 + 8 * i4 + 4 * hi;
                const u32x2 xx = *(const LAS u32x2*)(Xs + l * XPN + hh * 64 + p0);
                const float z[4] = {__uint_as_float(zz[pt][i4].x << 16), __uint_as_float(zz[pt][i4].x & 0xffff0000u), __uint_as_float(zz[pt][i4].y << 16), __uint_as_float(zz[pt][i4].y & 0xffff0000u)};
                const float xv[4] = {__uint_as_float(xx.x << 16), __uint_as_float(xx.x & 0xffff0000u), __uint_as_float(xx.y << 16), __uint_as_float(xx.y & 0xffff0000u)};
#pragma unroll
                for (int e = 0; e < 4; ++e) { const float y = (yd[li][pt][4 * i4 + e] + el * acc[pt][4 * i4 + e] + Dk * xv[e]) * silu_f(z[e]); yd[li][pt][4 * i4 + e] = y; ss += y * y; } }
        ss += __shfl_xor(ss, 32);
        if (hi == 0) red[hh * 128 + l] = ss;
        __builtin_amdgcn_sched_barrier(0);
    }
    __syncthreads();
    LAS bf16* stg = (LAS bf16*)F.lds + w * (64 * 72);
#pragma unroll
    for (int li = 0; li < 2; ++li) {
        const int lt = (li == 0) ? pr : 3 - pr, l = lt * 32 + r32;
        const float rstd = rsqrtf(((red[l] + red[128 + l]) + (red[256 + l] + red[384 + l])) * (1.f / 256.f) + EPS);
#pragma unroll
        for (int pt = 0; pt < 2; ++pt)
#pragma unroll
            for (int i4 = 0; i4 < 4; ++i4) { const int cl = pt * 32 + 8 * i4 + 4 * hi; const f32x4 gg = *(const f32x4*)(F.ssm_g + h * 64 + cl);
                u32x2 wv; wv.x = pk2(yd[li][pt][4 * i4 + 0] * rstd * gg[0], yd[li][pt][4 * i4 + 1] * rstd * gg[1]); wv.y = pk2(yd[li][pt][4 * i4 + 2] * rstd * gg[2], yd[li][pt][4 * i4 + 3] * rstd * gg[3]);
                *(LAS u32x2*)(stg + (li * 32 + r32) * 72 + cl) = wv; }
    }
    asm volatile("s_waitcnt lgkmcnt(0)" ::: "memory");
#pragma unroll
    for (int it = 0; it < 8; ++it) { const int row = it * 8 + (lane >> 3), ch = lane & 7;
        const int lt = (row < 32) ? pr : 3 - pr, l = lt * 32 + (row & 31);
        const u32x4 v = *(const LAS u32x4*)(stg + row * 72 + ch * 8);
        *(u32x4*)(Y + (size_t)(row0 + l) * D + h * 64 + ch * 8) = v; }
    __syncthreads();
}

#define XB_TMO      128
#define XB_XCNT(j)  (256  + 64 * (j))
#define XB_XSUB(j)  (1280 + 64 * (j))
#define XB_XGEN(j)  (2304 + 64 * (j))
#define XB_TOP      3328
#define XB_TOPGEN   3392
#define XCD_BAR_WORDS 3456
#define XB_SPIN_CAP (1u << 18)
DI unsigned xb_ld(unsigned* p)              { return __hip_atomic_load(p, __ATOMIC_RELAXED, __HIP_MEMORY_SCOPE_AGENT); }
DI unsigned xb_add(unsigned* p, unsigned v) { return __hip_atomic_fetch_add(p, v, __ATOMIC_RELAXED, __HIP_MEMORY_SCOPE_AGENT); }
DI unsigned xb_xcc_id() { return (unsigned)__builtin_amdgcn_s_getreg((3 << 11) | 20) & 0xFu; }
#define XB_SPIN(cond, bar) do { unsigned _sp = 0; while (cond) { __builtin_amdgcn_s_sleep(1); \
    if ((++_sp & 255u) == 0u) { if (xb_ld(&(bar)[XB_TMO])) break; if (_sp > XB_SPIN_CAP) { atomicAdd(&(bar)[XB_TMO], 1u); break; } } } } while (0)
struct XcdBarrier { unsigned* bar; unsigned x; volatile LAS unsigned* st; };
DI XcdBarrier xcd_barrier_post(unsigned* bar, volatile LAS unsigned* st) {
    XcdBarrier b; b.bar = bar; b.x = xb_xcc_id(); b.st = st;
    if (threadIdx.x == 0) (void)xb_add(&bar[XB_XCNT(b.x)], 1u);
    return b;
}
DI void xcd_barrier_complete(unsigned* bar, unsigned x, unsigned& nloc, unsigned& nx) {
    const unsigned G = gridDim.x * gridDim.y * gridDim.z;
    unsigned sum, cnt, mine, sp = 0u;
    for (;;) {
        sum = 0u; cnt = 0u; mine = 0u;
#pragma unroll
        for (unsigned j = 0; j < 16; ++j) { const unsigned c = xb_ld(&bar[XB_XCNT(j)]); sum += c; cnt += (c > 0u) ? 1u : 0u; mine = (j == x) ? c : mine; }
        if (sum == G) break;
        __builtin_amdgcn_s_sleep(1);
        if ((++sp & 255u) == 0u) { if (xb_ld(&bar[XB_TMO])) break; if (sp > XB_SPIN_CAP) { atomicAdd(&bar[XB_TMO], 1u); break; } }
    }
    nloc = mine > 0u ? mine : 1u; nx = cnt > 0u ? cnt : 1u;
}
DI void xcd_barrier(const XcdBarrier& b) {
    asm volatile("s_waitcnt vmcnt(0)" ::: "memory");
    __syncthreads();
    if (threadIdx.x == 0) {
        unsigned* bar = b.bar;
        __builtin_amdgcn_s_waitcnt(0);
        unsigned nloc = b.st[0], nx = b.st[1];
        if (nloc == 0u) { xcd_barrier_complete(bar, b.x, nloc, nx); b.st[0] = nloc; b.st[1] = nx; }
        const unsigned old = xb_add(&bar[XB_XSUB(b.x)], 1u);
        const unsigned gen = old / nloc;
        if (old + 1u == (gen + 1u) * nloc) {
            __builtin_amdgcn_fence(__ATOMIC_RELEASE, "agent");
            asm volatile("s_waitcnt vmcnt(0)" ::: "memory");
            const unsigned og = xb_add(&bar[XB_TOP], 1u);
            const unsigned tg = og / nx;
            if (og + 1u == (tg + 1u) * nx) xb_add(&bar[XB_TOPGEN], 1u);
            else XB_SPIN(xb_ld(&bar[XB_TOPGEN]) == tg, bar);
            __builtin_amdgcn_fence(__ATOMIC_ACQUIRE, "agent");
            xb_add(&bar[XB_XGEN(b.x)], 1u);
            asm volatile("s_waitcnt vmcnt(0)" ::: "memory");
        } else {
            XB_SPIN(xb_ld(&bar[XB_XGEN(b.x)]) == gen, bar);
            __builtin_amdgcn_fence(__ATOMIC_ACQUIRE, "agent");
            asm volatile("s_waitcnt vmcnt(0)" ::: "memory");
        }
    }
    __syncthreads();
}

__global__ void __launch_bounds__(512, 2) mk_fwd(Args args) {
    extern __shared__ __attribute__((aligned(16))) unsigned char lds_raw[];
    Frame F;
    F.lds = (LAS unsigned char*)lds_raw;
    F.tid = threadIdx.x; F.lane = F.tid & 63; F.wave = __builtin_amdgcn_readfirstlane(F.tid >> 6); F.G = gridDim.x; F.blk = blockIdx.x;
    F.x = args.in[0]; F.mix_g = args.in[1]; F.w_in = args.in[2]; F.conv_w = args.in[3]; F.conv_b = args.in[4]; F.dt_bias = args.in[5]; F.A_log = args.in[6]; F.D_skip = args.in[7];
    F.ssm_g = args.in[8]; F.sinks = args.in[9]; F.att_g = args.in[10]; F.w_out = args.in[11]; F.mlp_g = args.in[12]; F.w_up = args.in[13]; F.w_down = args.in[14]; F.fin_g = args.in[15];
    F.out = args.out; F.ws = args.ws;
    bf16* XN = (bf16*)(F.ws + WS_XN); bf16* PROJ = (bf16*)(F.ws + WS_PROJ); bf16* Y = (bf16*)(F.ws + WS_Y); bf16* H = (bf16*)(F.ws + WS_H);
    float* SSQ1 = (float*)(F.ws + WS_SSQ1); float* SSQ2 = (float*)(F.ws + WS_SSQ2);
    if (F.tid < 16) ((LAS unsigned*)(F.lds + MISC_OFF))[F.tid] = 0u;
    __syncthreads();
    const XcdBarrier xbar = xcd_barrier_post((unsigned*)F.ws, (volatile LAS unsigned*)(F.lds + MISC_OFF));
    f32x16 yd[2][2];
#pragma unroll
    for (int a_ = 0; a_ < 2; ++a_)
#pragma unroll
        for (int b_ = 0; b_ < 2; ++b_)
#pragma unroll
            for (int i_ = 0; i_ < 16; ++i_) yd[a_][b_][i_] = 0.f;
    const int lo = args.ph_lo, hi = args.ph_hi;
    if (hi > 1000) cg::this_grid().sync();
#define IN(k) (lo <= (k) && (k) < hi)
#define SEAM(k) do { if (IN(k) && IN((k) + 1)) { xcd_barrier(xbar); } } while (0)
#define PH0() if (IN(0)) { p0_prologue(F); } SEAM(0);
#define PH1() if (IN(1)) { \
        pg8::Gemm g{XN, (const bf16*)(F.ws + WS_WIN), M, NPROJ, D}; pg8::StaticOrder S; S.init(M, NPROJ, F.G, F.blk); S.rebal = (F.G == 256) ? 1 : 0; \
        pg8::Epi<0> E{PROJ, NPROJ, nullptr, nullptr, nullptr, nullptr, nullptr}; \
        pg8::gemm_phase(F.lds, g, S, E); \
        dt_gemm(F); p0b_weights(F); } SEAM(1);
#define PH2() if (IN(2)) { if (F.blk < 256) { attn_item(F, F.blk); if (MK_PROBE_PHASE == 21) attn_item(F, F.blk); ssd_front(F, F.blk, yd); } } SEAM(2); \
    if (MK_PROBE_PHASE == 30) { for (int q_ = 0; q_ < 10; ++q_) xcd_barrier(xbar); } \
    if (IN(3)) { ssd_scan(F); } SEAM(3); \
    if (IN(4)) { if (F.blk < 256) ssd_back(F, F.blk, yd); } SEAM(4);
#define PH5() if (IN(5)) { \
        pg8::Gemm g{Y, (const bf16*)(F.ws + WS_WOUT), M, D, D}; pg8::StaticOrder S; S.init(M, D, F.G, F.blk); \
        pg8::Epi<1> E{XN, D, F.x, nullptr, SSQ1, nullptr, nullptr}; \
        pg8::gemm_phase(F.lds, g, S, E); } SEAM(5);
#define PH6() if (IN(6)) { \
        pg8::Gemm g{XN, (const bf16*)(F.ws + WS_WUP), M, FF, D}; pg8::StaticOrder S; S.init(M, FF, F.G, F.blk); \
        pg8::Epi<2> E{H, FF, nullptr, nullptr, nullptr, SSQ1, nullptr}; \
        pg8::gemm_phase(F.lds, g, S, E); } SEAM(6);
    PH0();
#if MK_PROBE_PHASE == 0
    PH0();
#endif
    PH1();
#if MK_PROBE_PHASE == 1
    PH1();
#endif
    PH2();
#if MK_PROBE_PHASE == 2
    PH2();
#endif
    PH5();
#if MK_PROBE_PHASE == 5
    PH5();
#endif
    PH6();
#if MK_PROBE_PHASE == 6
    PH6();
#endif
#define PH7() if (IN(7)) { \
        pg8::Gemm g{H, (const bf16*)(F.ws + WS_WDN), M, D, FF}; pg8::StaticOrder S; S.init(M, D, F.G, F.blk); \
        pg8::Epi<3> E{XN, D, F.fin_g, F.out, SSQ2, nullptr, (unsigned*)F.ws + 4096}; \
        pg8::gemm_phase(F.lds, g, S, E); }
    PH7();
#if MK_PROBE_PHASE == 7
    xcd_barrier(xbar);
    PH7();
#endif
}


extern "C" void kernel_launch(void* const* d_in, const int* in_sizes, int n_in, void* d_out, int out_size, void* d_ws, size_t ws_size, hipStream_t stream) {
    static int grid = 0;
    if (grid == 0) {
        int dev = 0, cus = 0, per_cu = 0;
        (void)hipGetDevice(&dev); (void)hipDeviceGetAttribute(&cus, hipDeviceAttributeMultiprocessorCount, dev);
        if (hipFuncSetAttribute((const void*)mk_fwd, hipFuncAttributeMaxDynamicSharedMemorySize, LDS_BYTES) != hipSuccess) { fprintf(stderr, "hipFuncSetAttribute failed\n"); }
        if (hipOccupancyMaxActiveBlocksPerMultiprocessor(&per_cu, (const void*)mk_fwd, 512, LDS_BYTES) != hipSuccess || per_cu < 1) per_cu = 1;
        (void)hipGetLastError();
        if (per_cu > 1) per_cu = 1;
        grid = cus * per_cu;
        if (grid <= 0) grid = 256;
        if (grid != 256) fprintf(stderr, "kernel_launch: grid %d != 256: the fused final norm needs one down-GEMM unit per workgroup\n", grid);
    }
    Args a{};
    for (int i = 0; i < 16; ++i) a.in[i] = (const float*)d_in[i];
    a.out = (float*)d_out; a.ws = (unsigned char*)d_ws;
    a.ph_lo = 0; a.ph_hi = 9;
    (void)hipMemsetAsync(d_ws, 0, 32768, stream);
    void* kargs[] = {&a};
    hipError_t e = hipLaunchCooperativeKernel((const void*)mk_fwd, dim3(grid), dim3(512), kargs, LDS_BYTES, stream);
    if (e != hipSuccess) fprintf(stderr, "cooperative launch failed: %s (grid %d)\n", hipGetErrorString(e), grid);
}
```

```cpp
#include <hip/hip_runtime.h>
#include <hip/hip_cooperative_groups.h>
#include <cstdio>
#include <cstdint>
namespace cg = cooperative_groups;

#ifndef MK_PROBE_PHASE
#define MK_PROBE_PHASE -1
#endif

#define DI __device__ __forceinline__
#define LAS __attribute__((address_space(3)))
typedef unsigned short bf16;
typedef short bf16x8 __attribute__((ext_vector_type(8)));
typedef float f32x4 __attribute__((ext_vector_type(4)));
typedef float f32x2 __attribute__((ext_vector_type(2)));
typedef unsigned u32x4 __attribute__((ext_vector_type(4)));
typedef unsigned u32x2 __attribute__((ext_vector_type(2)));
typedef float f32x16 __attribute__((ext_vector_type(16)));
typedef __bf16 bf16x2_t __attribute__((ext_vector_type(2)));

constexpr int M = 8192, D = 2048, SEQ = 2048, NBATCH = 4;
constexpr int NIN = 4368, NPROJ = 4352;
constexpr int PZ = 0, PXBC = 1024, PQ = 3072, PK = 4096, PV = 4224;
constexpr int DT_COL = 3072;
constexpr int NH = 16, HD = 64, NG = 4, NS = 128, DINNER = 1024, CONVD = 2048;
constexpr int FF = 8192;
constexpr float EPS = 1e-5f;

constexpr size_t MiB = 1u << 20;
constexpr size_t WS_WUP = 2 * MiB, WS_WDN = 34 * MiB, WS_XN = 66 * MiB;
constexpr size_t WS_SSQ1 = 98 * MiB, WS_SSQ2 = 98 * MiB + 256 * 1024, WS_DT = 98 * MiB + 512 * 1024;
constexpr size_t WS_RS0 = 98 * MiB + 1280 * 1024;
constexpr size_t WS_H = 100 * MiB;
constexpr size_t WS_WIN = 100 * MiB, WS_WDT = 117 * MiB, WS_WOUT = 118 * MiB, WS_PROJ = 126 * MiB, WS_Y = 194 * MiB;
constexpr size_t WS_MISC = 228 * MiB;

constexpr int RING_BYTES = 131072, XLDS_OFF = RING_BYTES, LDS_BYTES = 149504 + 64, MISC_OFF = 149504;

DI float bf2f(bf16 v) { return __uint_as_float(((unsigned)v) << 16); }
DI unsigned f2bf(float f) { unsigned u = __float_as_uint(f); return (u + 0x7fffu + ((u >> 16) & 1u)) >> 16; }
DI unsigned pk2(float lo, float hi) { f32x2 v = {lo, hi}; bf16x2_t b = __builtin_convertvector(v, bf16x2_t); return __builtin_bit_cast(unsigned, b); }
DI float wave_sum(float v) {
#pragma unroll
    for (int o = 1; o < 64; o <<= 1) v += __shfl_xor(v, o);
    return v;
}
DI float silu_f(float x) { return x * __builtin_amdgcn_rcpf(1.f + __expf(-x)); }
DI float softplus_f(float x) { return x > 20.f ? x : log1pf(__expf(x)); }

namespace pg8 {
constexpr int BM = 256, BK = 64, HALF = 128, HTB = HALF * BK * 2, NXCD = 8, WGM = 8;
__host__ __device__ __forceinline__ int lds_byte(int r, int c) { const int st = (r >> 4) * 2 + (c >> 5), rr = r & 15, cc = c & 31, ob = rr * 64 + cc * 2; return st * 1024 + (ob ^ (((ob >> 9) & 1) << 5)); }
__host__ __device__ __forceinline__ void stage_rc(int b, int& R, int& C) { const int st = b / 1024, sb = b % 1024, swz = sb ^ (((sb >> 9) & 1) << 5); R = (st >> 1) * 16 + swz / 64; C = (st & 1) * 32 + (swz % 64) / 2; }
__host__ __device__ __forceinline__ int perm32(int rho) { const int n = rho >> 4, i = rho & 15; return 8 * (i >> 2) + 4 * n + (i & 3); }

struct Unit { int pm, pn; };
struct Gemm { const bf16* A; const bf16* Bt; int M, N, K; };
struct StaticOrder {
    int nM, nN, nwg, G, c;
    DI void init(int M_, int N_, int G_, int c_) { nM = M_ / BM; nN = N_ / BM; nwg = nM * nN; G = G_; c = c_; rebal = 0; }
    int rebal;
    DI bool next(int i, Unit& u) const {
        long L = (long)i * G + c;
        if (rebal) { if (i == 0) L = c; else if (i == 1) { if (c >= 144) return false; L = 256 + c; } else if (i == 2) { if (c >= 144) return false; L = 400 + c; } else return false; }
        if (L >= nwg) return false;
        int wgid = (int)L; { const int q = nwg / NXCD, r = nwg % NXCD, xcd = wgid % NXCD, off = wgid / NXCD; wgid = (xcd < r ? xcd * (q + 1) : r * (q + 1) + (xcd - r) * q) + off; }
        const int nig = WGM * nN, gid = wgid / nig, fm = gid * WGM, gsz = (nM - fm) < WGM ? (nM - fm) : WGM;
        u.pm = fm + ((wgid % nig) % gsz); u.pn = (wgid % nig) / gsz; return true;
    }
};

template <class Epi>
DI void gemm_phase(LAS unsigned char* lds, const Gemm g, const StaticOrder& S, const Epi& E) {
    const int tid = threadIdx.x, wid = __builtin_amdgcn_readfirstlane(tid >> 6), lane = tid & 63, wr = wid >> 2, wc = wid & 3, fr = lane & 15, fq = lane >> 4;
    const int K = g.K, nt = K / BK;
    unsigned voffA[2], voffB[2];
#pragma unroll
    for (int i = 0; i < 2; ++i) { int R, C; stage_rc(tid * 16 + i * 8192, R, C); const int Rb = (R & ~31) + perm32(R & 31);
        voffA[i] = (unsigned)(R * K + C) * 2u; voffB[i] = (unsigned)(Rb * K + C) * 2u; }
    const size_t kstep = (size_t)(BK * 2);
    const size_t hstep = (size_t)HALF * K * 2;
    const size_t tstep = 2 * hstep;
    const unsigned ldsw = (unsigned)wid * 1024u;
    const int aoff = lds_byte(wr * 64 + fr, fq * 8), boff = lds_byte(wc * 32 + fr, fq * 8);
#define PG8_SA(b, h) (((b) * 2 + (h)) * HTB)
#define PG8_SB(b, h) ((4 + (b) * 2 + (h)) * HTB)
#define PG8_STAGE(bufoff, gbase, voff) do { _Pragma("unroll") for (int _i = 0; _i < 2; ++_i) \
        __builtin_amdgcn_global_load_lds((const unsigned*)((const char*)(gbase) + (voff)[_i]), (LAS unsigned*)(lds + (bufoff) + ldsw + _i * 8192), 16, 0, 0); } while (0)
#define PG8_LDA(dst, b, h) do { _Pragma("unroll") for (int m = 0; m < 4; ++m) _Pragma("unroll") for (int k = 0; k < 2; ++k) dst[m][k] = *(const LAS bf16x8*)(lds + PG8_SA(b, h) + aoff + m * 2048 + k * 1024); } while (0)
#define PG8_LDB(dst, b, h) do { _Pragma("unroll") for (int n = 0; n < 2; ++n) _Pragma("unroll") for (int k = 0; k < 2; ++k) dst[n][k] = *(const LAS bf16x8*)(lds + PG8_SB(b, h) + boff + n * 2048 + k * 1024); } while (0)
#define PG8_MMA(ai, bj, At, Bt) do { __builtin_amdgcn_s_setprio(1); _Pragma("unroll") for (int m = 0; m < 4; ++m) _Pragma("unroll") for (int n = 0; n < 2; ++n) _Pragma("unroll") for (int k = 0; k < 2; ++k) \
        acc[ai][bj][m][n] = __builtin_amdgcn_mfma_f32_16x16x32_bf16(Bt[n][k], At[m][k], acc[ai][bj][m][n], 0, 0, 0); __builtin_amdgcn_s_setprio(0); } while (0)
#define PG8_WAIT_V(n) asm volatile("s_waitcnt vmcnt(" #n ")" ::: "memory")
#define PG8_WAIT_L(n) asm volatile("s_waitcnt lgkmcnt(" #n ")" ::: "memory")
#define PG8_BAR __builtin_amdgcn_s_barrier()
#define PG8_SCHED __builtin_amdgcn_sched_barrier(0)
    Unit cur, nxt; int ui = 0;
    if (!S.next(0, cur)) return;
    f32x4 acc[2][2][4][2];
#pragma unroll
    for (int a = 0; a < 2; ++a)
#pragma unroll
        for (int b = 0; b < 2; ++b)
#pragma unroll
            for (int m = 0; m < 4; ++m)
#pragma unroll
                for (int n = 0; n < 2; ++n) acc[a][b][m][n] = (f32x4){0.f, 0.f, 0.f, 0.f};
    bf16x8 At[4][2], B0[2][2], B1[2][2];
    const char* cA = (const char*)g.A + (size_t)cur.pm * tstep; const char* cB = (const char*)g.Bt + (size_t)cur.pn * tstep;
    PG8_STAGE(PG8_SB(0, 0), cB, voffB); PG8_STAGE(PG8_SB(0, 1), cB + hstep, voffB); PG8_STAGE(PG8_SA(0, 0), cA, voffA); PG8_STAGE(PG8_SA(0, 1), cA + hstep, voffA);
    if (wr == 1) PG8_BAR;
    PG8_WAIT_V(2); PG8_BAR;
    PG8_STAGE(PG8_SB(1, 0), cB + kstep, voffB); PG8_STAGE(PG8_SA(1, 0), cA + kstep, voffA); PG8_STAGE(PG8_SB(1, 1), cB + hstep + kstep, voffB);
    PG8_WAIT_V(6); PG8_BAR;
    for (;;) {
        const bool has_next = S.next(ui + 1, nxt);
        const char* nA = has_next ? (const char*)g.A + (size_t)nxt.pm * tstep : cA; const char* nB = has_next ? (const char*)g.Bt + (size_t)nxt.pn * tstep : cB;
        for (int t = 0; t < nt; t += 2) {
            const bool last = (t == nt - 2);
            const char* a1 = cA + (size_t)(t + 1) * kstep;
            const char* a2 = last ? nA : cA + (size_t)(t + 2) * kstep; const char* b2 = last ? nB : cB + (size_t)(t + 2) * kstep;
            const char* a3 = a2 + kstep; const char* b3 = b2 + kstep;
            PG8_LDB(B0, 0, 0); PG8_LDB(B1, 0, 1); PG8_SCHED; PG8_LDA(At, 0, 0); PG8_STAGE(PG8_SA(1, 1), a1 + hstep, voffA);
            PG8_WAIT_V(8); PG8_WAIT_L(0); PG8_BAR; PG8_MMA(0, 0, At, B0); PG8_MMA(0, 1, At, B1); PG8_BAR; PG8_SCHED;
            PG8_LDA(At, 0, 1); PG8_STAGE(PG8_SB(0, 0), b2, voffB); PG8_STAGE(PG8_SB(0, 1), b2 + hstep, voffB); PG8_STAGE(PG8_SA(0, 0), a2, voffA);
            PG8_WAIT_V(8); PG8_WAIT_L(0); PG8_BAR; PG8_MMA(1, 0, At, B0); PG8_MMA(1, 1, At, B1); PG8_BAR; PG8_SCHED;
            PG8_LDB(B0, 1, 0); PG8_LDB(B1, 1, 1); PG8_SCHED; PG8_LDA(At, 1, 0); PG8_STAGE(PG8_SA(0, 1), a2 + hstep, voffA);
            PG8_WAIT_V(8); PG8_WAIT_L(0); PG8_BAR; PG8_MMA(0, 0, At, B0); PG8_MMA(0, 1, At, B1); PG8_BAR; PG8_SCHED;
            PG8_LDA(At, 1, 1); PG8_STAGE(PG8_SB(1, 0), b3, voffB); PG8_STAGE(PG8_SB(1, 1), b3 + hstep, voffB); PG8_STAGE(PG8_SA(1, 0), a3, voffA);
            PG8_WAIT_V(8); PG8_WAIT_L(0); PG8_BAR; PG8_MMA(1, 0, At, B0); PG8_MMA(1, 1, At, B1); PG8_BAR; PG8_SCHED;
        }
        if (wr == 0) PG8_BAR;
        E(acc, cur, wr, wc, fr, fq, lds + XLDS_OFF);
        if (!has_next) break;
#pragma unroll
        for (int a = 0; a < 2; ++a)
#pragma unroll
            for (int b = 0; b < 2; ++b)
#pragma unroll
                for (int m = 0; m < 4; ++m)
#pragma unroll
                    for (int n = 0; n < 2; ++n) acc[a][b][m][n] = (f32x4){0.f, 0.f, 0.f, 0.f};
        cur = nxt; cA = nA; cB = nB; ++ui;
        if (wr == 1) PG8_BAR;
    }
    PG8_WAIT_V(0);
    PG8_BAR;
#undef PG8_SA
#undef PG8_SB
#undef PG8_STAGE
#undef PG8_LDA
#undef PG8_LDB
#undef PG8_MMA
#undef PG8_WAIT_V
#undef PG8_WAIT_L
#undef PG8_BAR
#undef PG8_SCHED
}

template <int MODE> struct Epi {
    bf16* O; int ldc; const float* base; float* outf; float* ssq; const float* ssq_in; unsigned* cnt;
    DI void operator()(f32x4 (&acc)[2][2][4][2], const Unit& u, int wr, int wc, int fr, int fq, LAS unsigned char* xl) const {
        const int row0 = u.pm * BM + wr * 64 + fr, col0 = u.pn * BM + wc * 32 + 8 * fq;
        if (MODE == 0) {
#pragma unroll
            for (int ai = 0; ai < 2; ++ai)
#pragma unroll
                for (int m = 0; m < 4; ++m) { bf16* rowp = O + (size_t)(row0 + ai * HALF + m * 16) * ldc + col0; const float rs = ssq_in[row0 + ai * HALF + m * 16];
#pragma unroll
                    for (int bj = 0; bj < 2; ++bj) { const f32x4 v0 = acc[ai][bj][m][0] * rs, v1 = acc[ai][bj][m][1] * rs;
                        u32x4 w; w.x = pk2(v0[0], v0[1]); w.y = pk2(v0[2], v0[3]); w.z = pk2(v1[0], v1[1]); w.w = pk2(v1[2], v1[3]);
                        *(u32x4*)(rowp + bj * HALF) = w; } }
        } else if (MODE == 1) {
            LAS float* P = (LAS float*)xl;
#pragma unroll
            for (int ai = 0; ai < 2; ++ai)
#pragma unroll
                for (int m = 0; m < 4; ++m) { const int rl = ai * HALF + wr * 64 + m * 16 + fr; const size_t off = (size_t)(u.pm * BM + rl) * ldc + col0; float ss = 0.f;
#pragma unroll
                    for (int bj = 0; bj < 2; ++bj) {
                        f32x4 x0, x1;
                        if (base) { x0 = __builtin_nontemporal_load((const f32x4*)(base + off + bj * HALF)); x1 = __builtin_nontemporal_load((const f32x4*)(base + off + bj * HALF + 4)); }
                        else { const u32x4 xb = __builtin_nontemporal_load((const u32x4*)(O + off + bj * HALF));
                            x0[0] = __uint_as_float(xb.x << 16); x0[1] = __uint_as_float(xb.x & 0xffff0000u); x0[2] = __uint_as_float(xb.y << 16); x0[3] = __uint_as_float(xb.y & 0xffff0000u);
                            x1[0] = __uint_as_float(xb.z << 16); x1[1] = __uint_as_float(xb.z & 0xffff0000u); x1[2] = __uint_as_float(xb.w << 16); x1[3] = __uint_as_float(xb.w & 0xffff0000u); }
                        const f32x4 v0 = acc[ai][bj][m][0] + x0, v1 = acc[ai][bj][m][1] + x1;
                        if (outf) { *(f32x4*)(outf + off + bj * HALF) = v0; *(f32x4*)(outf + off + bj * HALF + 4) = v1; }
                        if (O) { u32x4 w; w.x = pk2(v0[0], v0[1]); w.y = pk2(v0[2], v0[3]); w.z = pk2(v1[0], v1[1]); w.w = pk2(v1[2], v1[3]); *(u32x4*)(O + off + bj * HALF) = w; }
                        ss += (v0[0] * v0[0] + v0[1] * v0[1]) + (v0[2] * v0[2] + v0[3] * v0[3]) + (v1[0] * v1[0] + v1[1] * v1[1]) + (v1[2] * v1[2] + v1[3] * v1[3]);
                    }
                    ss += __shfl_xor(ss, 16); ss += __shfl_xor(ss, 32);
                    if (fq == 0) P[rl * 4 + wc] = ss; }
            asm volatile("s_waitcnt lgkmcnt(0)" ::: "memory"); __builtin_amdgcn_s_barrier(); asm volatile("" ::: "memory");
            if (threadIdx.x < 256) { const int t = threadIdx.x; const float s = (P[t * 4 + 0] + P[t * 4 + 1]) + (P[t * 4 + 2] + P[t * 4 + 3]); ssq[(size_t)(u.pm * BM + t) * 8 + u.pn] = s; }
            asm volatile("s_waitcnt lgkmcnt(0)" ::: "memory"); __builtin_amdgcn_s_barrier(); asm volatile("" ::: "memory");
        } else if (MODE == 3) {
            LAS float* P = (LAS float*)xl; LAS float* R = (LAS float*)(xl + 4096);
#pragma unroll
            for (int ai = 0; ai < 2; ++ai)
#pragma unroll
                for (int m = 0; m < 4; ++m) { const int rl = ai * HALF + wr * 64 + m * 16 + fr; const size_t off = (size_t)(u.pm * BM + rl) * ldc + col0; float ss = 0.f;
#pragma unroll
                    for (int bj = 0; bj < 2; ++bj) { const u32x4 xb = __builtin_nontemporal_load((const u32x4*)(O + off + bj * HALF));
                        f32x4 v0 = acc[ai][bj][m][0], v1 = acc[ai][bj][m][1];
                        v0[0] += __uint_as_float(xb.x << 16); v0[1] += __uint_as_float(xb.x & 0xffff0000u); v0[2] += __uint_as_float(xb.y << 16); v0[3] += __uint_as_float(xb.y & 0xffff0000u);
                        v1[0] += __uint_as_float(xb.z << 16); v1[1] += __uint_as_float(xb.z & 0xffff0000u); v1[2] += __uint_as_float(xb.w << 16); v1[3] += __uint_as_float(xb.w & 0xffff0000u);
                        acc[ai][bj][m][0] = v0; acc[ai][bj][m][1] = v1;
                        ss += (v0[0] * v0[0] + v0[1] * v0[1]) + (v0[2] * v0[2] + v0[3] * v0[3]) + (v1[0] * v1[0] + v1[1] * v1[1]) + (v1[2] * v1[2] + v1[3] * v1[3]); }
                    ss += __shfl_xor(ss, 16); ss += __shfl_xor(ss, 32);
                    if (fq == 0) P[rl * 4 + wc] = ss; }
            asm volatile("s_waitcnt lgkmcnt(0)" ::: "memory"); __builtin_amdgcn_s_barrier(); asm volatile("" ::: "memory");
            const int t = threadIdx.x;
            if (t < 256) { const float sp = (P[t * 4 + 0] + P[t * 4 + 1]) + (P[t * 4 + 2] + P[t * 4 + 3]);
                __hip_atomic_store(ssq + (size_t)(u.pm * BM + t) * 8 + u.pn, sp, __ATOMIC_RELAXED, __HIP_MEMORY_SCOPE_AGENT); }
            asm volatile("s_waitcnt vmcnt(0)" ::: "memory"); __builtin_amdgcn_s_barrier(); asm volatile("" ::: "memory");
            if (t == 0) {
                __hip_atomic_fetch_add(cnt + 64 * u.pm, 1u, __ATOMIC_RELAXED, __HIP_MEMORY_SCOPE_AGENT);
                unsigned sp_ = 0;
                while (__hip_atomic_load(cnt + 64 * u.pm, __ATOMIC_RELAXED, __HIP_MEMORY_SCOPE_AGENT) < 8u) { __builtin_amdgcn_s_sleep(1); if (++sp_ > (1u << 22)) break; }
                __builtin_amdgcn_fence(__ATOMIC_ACQUIRE, "agent");
            }
            asm volatile("s_waitcnt vmcnt(0) lgkmcnt(0)" ::: "memory"); __builtin_amdgcn_s_barrier(); asm volatile("" ::: "memory");
            if (t < 256) { float tot = 0.f;
#pragma unroll
                for (int j = 0; j < 8; ++j) tot += __hip_atomic_load(ssq + (size_t)(u.pm * BM + t) * 8 + j, __ATOMIC_RELAXED, __HIP_MEMORY_SCOPE_AGENT);
                R[t] = rsqrtf(tot * (1.f / 2048.f) + EPS); }
            asm volatile("s_waitcnt vmcnt(0) lgkmcnt(0)" ::: "memory"); __builtin_amdgcn_s_barrier(); asm volatile("" ::: "memory");
            f32x4 gv[2][2];
#pragma unroll
            for (int bj = 0; bj < 2; ++bj) { gv[bj][0] = *(const f32x4*)(base + col0 + bj * HALF); gv[bj][1] = *(const f32x4*)(base + col0 + bj * HALF + 4); }
#pragma unroll
            for (int ai = 0; ai < 2; ++ai)
#pragma unroll
                for (int m = 0; m < 4; ++m) { const int rl = ai * HALF + wr * 64 + m * 16 + fr; const size_t off = (size_t)(u.pm * BM + rl) * ldc + col0; const float rstd = R[rl];
#pragma unroll
                    for (int bj = 0; bj < 2; ++bj) { *(f32x4*)(outf + off + bj * HALF) = acc[ai][bj][m][0] * rstd * gv[bj][0]; *(f32x4*)(outf + off + bj * HALF + 4) = acc[ai][bj][m][1] * rstd * gv[bj][1]; } }
        } else {
#pragma unroll
            for (int ai = 0; ai < 2; ++ai)
#pragma unroll
                for (int m = 0; m < 4; ++m) { const int row = row0 + ai * HALF + m * 16;
                    const f32x4 s0 = *(const f32x4*)(ssq_in + (size_t)row * 8), s1 = *(const f32x4*)(ssq_in + (size_t)row * 8 + 4);
                    const float rstd = rsqrtf(((s0[0] + s0[1]) + (s0[2] + s0[3]) + (s1[0] + s1[1]) + (s1[2] + s1[3])) * (1.f / 2048.f) + EPS);
                    bf16* rowp = O + (size_t)row * ldc + col0;
#pragma unroll
                    for (int bj = 0; bj < 2; ++bj) { f32x4 v0 = acc[ai][bj][m][0] * rstd, v1 = acc[ai][bj][m][1] * rstd;
#pragma unroll
                        for (int e = 0; e < 4; ++e) { const float a = fmaxf(v0[e], 0.f), b = fmaxf(v1[e], 0.f); v0[e] = a * a; v1[e] = b * b; }
                        u32x4 w; w.x = pk2(v0[0], v0[1]); w.y = pk2(v0[2], v0[3]); w.z = pk2(v1[0], v1[1]); w.w = pk2(v1[2], v1[3]);
                        *(u32x4*)(rowp + bj * HALF) = w; } }
        }
    }
};
}

struct Args { const float* in[16]; float* out; unsigned char* ws; int ph_lo, ph_hi; };

struct Frame {
    LAS unsigned char* lds; int tid, lane, wave, G, blk;
    const float *x, *mix_g, *w_in, *conv_w, *conv_b, *dt_bias, *A_log, *D_skip, *ssm_g, *sinks, *att_g, *w_out, *mlp_g, *w_up, *w_down, *fin_g;
    float* out; unsigned char* ws;
};

DI void p0_transpose_item(const float* W, int ldw, int src_col0, bf16* WT, int K, int dst_row0, const float* gs, LAS float* scr, int kb, int nb, int lane) {
    const int k0 = 64 * kb, n0 = 32 * nb;
    float v[32];
#pragma unroll
    for (int i = 0; i < 32; ++i) { const int kk = 2 * i + (lane >> 5); v[i] = __builtin_nontemporal_load(W + (size_t)(k0 + kk) * ldw + src_col0 + n0 + (lane & 31)); }
    if (gs) {
#pragma unroll
        for (int i = 0; i < 32; ++i) v[i] *= gs[k0 + 2 * i + (lane >> 5)]; }
#pragma unroll
    for (int i = 0; i < 32; ++i) scr[(2 * i + (lane >> 5)) * 33 + (lane & 31)] = v[i];
    asm volatile("s_waitcnt lgkmcnt(0)" ::: "memory");
    const int c = lane & 7;
#pragma unroll
    for (int j = 0; j < 4; ++j) { const int n = (lane >> 3) + 8 * j; const LAS float* s = scr + (8 * c) * 33 + n;
        u32x4 o; o.x = pk2(s[0 * 33], s[1 * 33]); o.y = pk2(s[2 * 33], s[3 * 33]); o.z = pk2(s[4 * 33], s[5 * 33]); o.w = pk2(s[6 * 33], s[7 * 33]);
        *(u32x4*)(WT + (size_t)(dst_row0 + n0 + n) * K + k0 + 8 * c) = o; }
    asm volatile("s_waitcnt lgkmcnt(0)" ::: "memory");
}
DI void p0_prologue(Frame& F) {
    LAS float* scr = (LAS float*)(F.lds + F.wave * 16384);
    const int gw = F.blk * 8 + F.wave, NGW = F.G * 8;
    bf16* Win_t = (bf16*)(F.ws + WS_WIN);
    bf16* Wdt_t = (bf16*)(F.ws + WS_WDT); bf16* XN = (bf16*)(F.ws + WS_XN);
    constexpr int I_A = 32 * 96, I_B = 32 * 40;
    constexpr int NITEMS = I_A + I_B;
    for (int it = gw; it < NITEMS; it += NGW) {
        int r = it;
        if (r < I_A) { p0_transpose_item(F.w_in, NIN, 0, Win_t, D, 0, F.mix_g, scr, r / 96, r % 96, F.lane); continue; } r -= I_A;
        p0_transpose_item(F.w_in, NIN, DT_COL + 16, Win_t, D, DT_COL, F.mix_g, scr, r / 40, r % 40, F.lane);
    }
    for (int i = F.blk * 512 + F.tid; i < 16 * D; i += F.G * 512) { const int j = i / D, k = i % D; Wdt_t[i] = (bf16)f2bf(F.w_in[(size_t)k * NIN + DT_COL + j] * F.mix_g[k]); }
    {
        f32x4 v[8], nv[8];
        int m = gw;
        if (m < M) {
            const f32x4* xr = (const f32x4*)(F.x + (size_t)m * D) + F.lane;
#pragma unroll
            for (int j = 0; j < 8; ++j) v[j] = __builtin_nontemporal_load(xr + 64 * j);
        }
        for (; m < M; m += NGW) {
            const int mn = m + NGW;
            if (mn < M) { const f32x4* xr = (const f32x4*)(F.x + (size_t)mn * D) + F.lane;
#pragma unroll
                for (int j = 0; j < 8; ++j) nv[j] = __builtin_nontemporal_load(xr + 64 * j); }
            float s = 0.f;
#pragma unroll
            for (int j = 0; j < 8; ++j) s += (v[j][0] * v[j][0] + v[j][1] * v[j][1]) + (v[j][2] * v[j][2] + v[j][3] * v[j][3]);
            const float rstd = rsqrtf(wave_sum(s) * (1.f / D) + EPS);
            u32x2* o8 = (u32x2*)(XN + (size_t)m * D) + F.lane;
#pragma unroll
            for (int j = 0; j < 8; ++j) { u32x2 w; w.x = pk2(v[j][0], v[j][1]); w.y = pk2(v[j][2], v[j][3]); o8[64 * j] = w; }
            if (F.lane == 0) ((float*)(F.ws + WS_RS0))[m] = rstd;
#pragma unroll
            for (int j = 0; j < 8; ++j) v[j] = nv[j];
        }
    }
}

struct TrItem { const float* W; bf16* WT; const float* gs; int ldw, K, k0, n0; };
DI TrItem p0b_decode(const Frame& F, int r) {
    constexpr int I_O = 32 * 64, I_U = 32 * 256;
    TrItem t;
    if (r < I_O) { t.W = F.w_out; t.WT = (bf16*)(F.ws + WS_WOUT); t.gs = nullptr; t.ldw = D; t.K = D; t.k0 = 64 * (r / 64); t.n0 = 32 * (r % 64); return t; } r -= I_O;
    if (r < I_U) { t.W = F.w_up; t.WT = (bf16*)(F.ws + WS_WUP); t.gs = F.mlp_g; t.ldw = FF; t.K = D; t.k0 = 64 * (r / 256); t.n0 = 32 * (r % 256); return t; } r -= I_U;
    t.W = F.w_down; t.WT = (bf16*)(F.ws + WS_WDN); t.gs = nullptr; t.ldw = D; t.K = FF; t.k0 = 64 * (r / 64); t.n0 = 32 * (r % 64); return t;
}
DI void p0b_load(const TrItem& t, int lane, float (&v)[32]) {
    const float* p = t.W + (size_t)(t.k0 + (lane >> 5)) * t.ldw + t.n0 + (lane & 31);
#pragma unroll
    for (int i = 0; i < 32; ++i) v[i] = __builtin_nontemporal_load(p + (size_t)(2 * i) * t.ldw);
}
DI void p0b_weights(Frame& F) {
    LAS float* scr = (LAS float*)(F.lds + F.wave * 16384);
    constexpr int NIT_ALL = 32 * 64 + 32 * 256 + 128 * 64, NIT_EARLY = 9216;
    const int lane = F.lane;
    int it, stride, NIT;
    if (F.G == 256) {
        if (F.blk < 144) return;
        it = (F.blk - 144) * 8 + F.wave; stride = 896; NIT = NIT_ALL;
    } else {
        const int nb = (F.G > 32) ? F.G - 32 : F.G, vb = (F.G > 32) ? F.blk - 32 : F.blk;
        if (vb < 0) return;
        it = vb * 8 + F.wave; stride = nb * 8; NIT = NIT_ALL;
    }
    if (it >= NIT) return;
    TrItem cur = p0b_decode(F, it);
    float v[32]; p0b_load(cur, lane, v);
    for (;;) {
        const int nx = it + stride; const bool more = nx < NIT;
        TrItem nxt = cur; float w[32];
        if (more) { nxt = p0b_decode(F, nx); p0b_load(nxt, lane, w); }
#pragma unroll
        for (int i = 0; i < 32; ++i) scr[(2 * i + (lane >> 5)) * 33 + (lane & 31)] = v[i];
        asm volatile("s_waitcnt lgkmcnt(0)" ::: "memory");
        const int c = lane & 7;
        float g8[8];
#pragma unroll
        for (int e = 0; e < 8; ++e) g8[e] = 1.f;
        if (cur.gs) { const f32x4 g0 = *(const f32x4*)(cur.gs + cur.k0 + 8 * c), g1 = *(const f32x4*)(cur.gs + cur.k0 + 8 * c + 4);
#pragma unroll
            for (int e = 0; e < 4; ++e) { g8[e] = g0[e]; g8[4 + e] = g1[e]; } }
#pragma unroll
        for (int j = 0; j < 4; ++j) { const int n = (lane >> 3) + 8 * j; const LAS float* sp = scr + (8 * c) * 33 + n;
            u32x4 o; o.x = pk2(sp[0 * 33] * g8[0], sp[1 * 33] * g8[1]); o.y = pk2(sp[2 * 33] * g8[2], sp[3 * 33] * g8[3]); o.z = pk2(sp[4 * 33] * g8[4], sp[5 * 33] * g8[5]); o.w = pk2(sp[6 * 33] * g8[6], sp[7 * 33] * g8[7]);
            *(u32x4*)(cur.WT + (size_t)(cur.n0 + n) * cur.K + cur.k0 + 8 * c) = o; }
        asm volatile("s_waitcnt lgkmcnt(0)" ::: "memory");
        if (!more) break;
        it = nx; cur = nxt;
#pragma unroll
        for (int i = 0; i < 32; ++i) v[i] = w[i];
    }
}

DI void dt_gemm(Frame& F) {
    const bf16* XN = (const bf16*)(F.ws + WS_XN); const bf16* Wdt_t = (const bf16*)(F.ws + WS_WDT); float* DT = (float*)(F.ws + WS_DT);
    const int skip = (F.G == 256) ? 144 : ((F.G > 32) ? 32 : 0);
    const int nb = F.G - skip, vb = F.blk - skip;
    if (vb < 0) return;
    LAS f32x4* part = (LAS f32x4*)F.lds;
    const int fr = F.lane & 15, fq = F.lane >> 4, rgl = F.wave >> 2, kp = F.wave & 3;
    for (int pair = vb; pair < M / 32; pair += nb) {
        const int rg = pair * 2 + rgl;
        const bf16* ap = XN + (size_t)(rg * 16 + fr) * D + kp * 512 + fq * 8; const bf16* bp = Wdt_t + (size_t)fr * D + kp * 512 + fq * 8;
        bf16x8 av[16], bv[16];
#pragma unroll
        for (int k = 0; k < 16; ++k) { av[k] = *(const bf16x8*)(ap + 32 * k); bv[k] = *(const bf16x8*)(bp + 32 * k); }
        f32x4 acc = {0.f, 0.f, 0.f, 0.f};
#pragma unroll
        for (int k = 0; k < 16; ++k) acc = __builtin_amdgcn_mfma_f32_16x16x32_bf16(av[k], bv[k], acc, 0, 0, 0);
        part[F.wave * 64 + F.lane] = acc;
        __syncthreads();
        if (kp == 0) { const f32x4 t = (part[(rgl * 4 + 0) * 64 + F.lane] + part[(rgl * 4 + 1) * 64 + F.lane]) + (part[(rgl * 4 + 2) * 64 + F.lane] + part[(rgl * 4 + 3) * 64 + F.lane]);
#pragma unroll
            for (int jj = 0; jj < 4; ++jj) { const int rr = rg * 16 + fq * 4 + jj; DT[(size_t)rr * 16 + fr] = t[jj] * ((const float*)(F.ws + WS_RS0))[rr]; } }
        __syncthreads();
    }
}


#define MFMA32(a, b, c) __builtin_amdgcn_mfma_f32_32x32x16_bf16((a), (b), (c), 0, 0, 0)
DI int crow(int i, int hi) { return (i & 3) + 8 * (i >> 2) + 4 * hi; }
DI bf16x8 pack8(const f32x16& x, int s) {
    u32x4 p; p.x = pk2(x[8 * s + 0], x[8 * s + 1]); p.y = pk2(x[8 * s + 2], x[8 * s + 3]); p.z = pk2(x[8 * s + 4], x[8 * s + 5]); p.w = pk2(x[8 * s + 6], x[8 * s + 7]);
    return __builtin_bit_cast(bf16x8, p);
}
typedef short v4i16_t __attribute__((ext_vector_type(4)));
DI v4i16_t tr4(const LAS bf16* p) { return __builtin_amdgcn_ds_read_tr16_b64_v4i16((LAS v4i16_t*)p); }
DI bf16x8 tr_frag(const LAS bf16* T, int P, int Ra, int Rb, int cbase, int lane) {
    const int q = (lane & 15) >> 2, p4 = lane & 3, blk = (lane >> 4) & 1, co = cbase + 16 * blk + 4 * p4;
    const v4i16_t lo = tr4(T + (Ra + q) * P + co), hi = tr4(T + (Rb + q) * P + co);
    return (bf16x8){lo[0], lo[1], lo[2], lo[3], hi[0], hi[1], hi[2], hi[3]};
}
constexpr int KS_PITCH = 72;
DI void attn_item(Frame& F, int item) {
    const bf16* proj = (const bf16*)(F.ws + WS_PROJ); bf16* Y = (bf16*)(F.ws + WS_Y);
    LAS bf16* Vs = (LAS bf16*)F.lds;
    LAS bf16* Ks = (LAS bf16*)(F.lds + 2 * 160 * KS_PITCH * 2);
    LAS float* red = (LAS float*)(F.lds + 4 * 160 * KS_PITCH * 2);
    const int b = item >> 6, l0 = (item & 63) * 32, t0 = b * SEQ + l0, tmin = b * SEQ;
    const int lane = F.lane, r32 = lane & 31, hi = lane >> 5, w = F.wave;
    bf16x8 qf[2][4];
#pragma unroll
    for (int hh = 0; hh < 2; ++hh)
#pragma unroll
        for (int s = 0; s < 4; ++s) qf[hh][s] = __builtin_nontemporal_load((const bf16x8*)(proj + (size_t)(t0 + r32) * NPROJ + PQ + (2 * w + hh) * 64 + 16 * s + 8 * hi));
#pragma unroll
    for (int j = 0; j < 10; ++j) { const int rr = (j * 8 + w) * 8 + (lane >> 3), ch = lane & 7;
        const int tsel = rr / 320, rem = rr % 320, kvh = rem / 160, kk = rem % 160;
        int row = t0 - 128 + kk; if (row < tmin) row = tmin;
        const bf16x8 v = *(const bf16x8*)(proj + (size_t)row * NPROJ + (tsel ? PV : PK) + kvh * 64 + ch * 8);
        *(LAS bf16x8*)((tsel ? Vs : Ks) + (kvh * 160 + kk) * KS_PITCH + ch * 8) = v; }
    __syncthreads();
    const int kv = w >> 2;
    f32x16 o[2][2]; float ssq = 0.f;
#pragma unroll
    for (int hh = 0; hh < 2; ++hh) {
        const int hq = 2 * w + hh;
        f32x16 S[5];
#pragma unroll
        for (int tile = 0; tile < 5; ++tile) {
            const LAS bf16* kp = Ks + (kv * 160 + tile * 32 + r32) * KS_PITCH + 8 * hi;
            f32x16 a;
#pragma unroll
            for (int i = 0; i < 16; ++i) a[i] = 0.f;
#pragma unroll
            for (int s = 0; s < 4; ++s) { const bf16x8 kf = *(const LAS bf16x8*)(kp + 16 * s); a = MFMA32(kf, qf[hh][s], a); }
            S[tile] = a;
        }
        __builtin_amdgcn_sched_barrier(0);
        constexpr float SC2 = 0.125f * 1.4426950408889634f;
        const float sink = F.sinks[hq] * 1.4426950408889634f; float mx = sink;
#pragma unroll
        for (int tile = 0; tile < 5; ++tile) { const bool tv = (l0 + 32 * tile >= 128);
#pragma unroll
            for (int i = 0; i < 16; ++i) { bool valid;
                if (tile == 0) valid = tv && (crow(i, hi) > r32); else if (tile == 4) valid = (crow(i, hi) <= r32); else valid = tv;
                const float sv = valid ? S[tile][i] * SC2 : -INFINITY; S[tile][i] = sv; mx = fmaxf(mx, sv); } }
        mx = fmaxf(mx, __shfl_xor(mx, 32));
        float den = 0.f;
#pragma unroll
        for (int tile = 0; tile < 5; ++tile)
#pragma unroll
            for (int i = 0; i < 16; ++i) { const float p = __builtin_amdgcn_exp2f(S[tile][i] - mx); S[tile][i] = p; den += p; }
        den += __shfl_xor(den, 32); den += __builtin_amdgcn_exp2f(sink - mx);
        const float inv = 1.f / den;
        __builtin_amdgcn_sched_barrier(0);
        f32x16 oT[2];
#pragma unroll
        for (int dh = 0; dh < 2; ++dh)
#pragma unroll
            for (int i = 0; i < 16; ++i) oT[dh][i] = 0.f;
#pragma unroll
        for (int tile = 0; tile < 5; ++tile)
#pragma unroll
            for (int s2 = 0; s2 < 2; ++s2) { const bf16x8 pf = pack8(S[tile], s2);
#pragma unroll
                for (int dh = 0; dh < 2; ++dh) { const bf16x8 va = tr_frag(Vs + kv * 160 * KS_PITCH, KS_PITCH, tile * 32 + 16 * s2 + 4 * hi, tile * 32 + 16 * s2 + 4 * hi + 8, dh * 32, lane); oT[dh] = MFMA32(va, pf, oT[dh]); } }
#pragma unroll
        for (int dh = 0; dh < 2; ++dh)
#pragma unroll
            for (int i = 0; i < 16; ++i) { const float v = oT[dh][i] * inv; o[hh][dh][i] = v; ssq += v * v; }
        __builtin_amdgcn_sched_barrier(0);
    }
    ssq += __shfl_xor(ssq, 32);
    if (hi == 0) red[w * 32 + r32] = ssq;
    __syncthreads();
    float tot = 0.f;
#pragma unroll
    for (int ww = 0; ww < 8; ++ww) tot += red[ww * 32 + r32];
    const float rstd = rsqrtf(tot * (1.f / 1024.f) + EPS);
    LAS bf16* stg = (LAS bf16*)F.lds + w * (32 * 136);
#pragma unroll
    for (int hh = 0; hh < 2; ++hh)
#pragma unroll
        for (int dh = 0; dh < 2; ++dh)
#pragma unroll
            for (int i4 = 0; i4 < 4; ++i4) { const int cl = hh * 64 + dh * 32 + 8 * i4 + 4 * hi; const f32x4 g = *(const f32x4*)(F.att_g + w * 128 + cl);
                u32x2 wv; wv.x = pk2(o[hh][dh][4 * i4 + 0] * rstd * g[0], o[hh][dh][4 * i4 + 1] * rstd * g[1]); wv.y = pk2(o[hh][dh][4 * i4 + 2] * rstd * g[2], o[hh][dh][4 * i4 + 3] * rstd * g[3]);
                *(LAS u32x2*)(stg + r32 * 136 + cl) = wv; }
    asm volatile("s_waitcnt lgkmcnt(0)" ::: "memory");
#pragma unroll
    for (int it = 0; it < 8; ++it) { const int row = it * 4 + (lane >> 4), ch = lane & 15;
        const u32x4 v = *(const LAS u32x4*)(stg + row * 136 + ch * 8);
        *(u32x4*)(Y + (size_t)(t0 + row) * D + DINNER + w * 128 + ch * 8) = v; }
    __syncthreads();
}
constexpr int XPN = 272, BPN = 144;
constexpr int L_X = 0, L_B = 128 * XPN * 2, L_C = L_B + 128 * BPN * 2, L_TDT = L_C + 128 * BPN * 2, L_TACS = L_TDT + 2048, L_RED = L_TACS + 2048;
static_assert(L_RED + 2048 <= LDS_BYTES, "LDS map of the SSD items");
constexpr size_t WS_PREV = WS_MISC, WS_CD = WS_MISC + 16 * MiB;
DI void ssd_tables(Frame& F, int row0, int g, LAS float* tdt, LAS float* tacs) {
    const float* DT = (const float*)(F.ws + WS_DT);
    const int hh = F.wave >> 1, s = (F.wave & 1) * 64 + F.lane, h = g * 4 + hh;
    const float dtv = softplus_f(DT[(size_t)(row0 + s) * 16 + h] + F.dt_bias[h]);
    float v = dtv * (-__expf(F.A_log[h]));
#pragma unroll
    for (int o = 1; o < 64; o <<= 1) { const float u = __shfl_up(v, o); if (F.lane >= o) v += u; }
    tdt[hh * 128 + s] = dtv; if (!(F.wave & 1)) tacs[hh * 128 + s] = v;
    __syncthreads();
    if (F.wave & 1) tacs[hh * 128 + s] = v + tacs[hh * 128 + 63];
    __syncthreads();
}
struct ConvRegs { bf16x8 v[19]; float wk[4][8]; float bb[8]; };
template <bool STATE> DI void conv_issue(Frame& F, const bf16* proj, int row0, int l00, int g, ConvRegs& R) {
    const int ck = F.lane, seg = F.wave;
    int ch0;
    if (ck < 32) ch0 = g * 256 + ck * 8; else if (ck < 48) ch0 = DINNER + g * 128 + (ck - 32) * 8; else ch0 = DINNER + 512 + g * 128 + (ck - 48) * 8;
    const bf16* src = proj + (size_t)(row0 + seg * 16 - 3) * NPROJ + PXBC + ch0;
#pragma unroll
    for (int r = 0; r < 19; ++r) { if (l00 + seg * 16 - 3 + r >= 0) R.v[r] = __builtin_nontemporal_load((const bf16x8*)(src + (size_t)r * NPROJ)); else R.v[r] = (bf16x8){0, 0, 0, 0, 0, 0, 0, 0}; }
#pragma unroll
    for (int k = 0; k < 4; ++k) { const f32x4 w0 = *(const f32x4*)(F.conv_w + k * CONVD + ch0), w1 = *(const f32x4*)(F.conv_w + k * CONVD + ch0 + 4);
#pragma unroll
        for (int e = 0; e < 4; ++e) { R.wk[k][e] = w0[e]; R.wk[k][4 + e] = w1[e]; } }
    { const f32x4 b0 = *(const f32x4*)(F.conv_b + ch0), b1 = *(const f32x4*)(F.conv_b + ch0 + 4);
#pragma unroll
      for (int e = 0; e < 4; ++e) { R.bb[e] = b0[e]; R.bb[4 + e] = b1[e]; } }
}
template <bool STATE> DI void conv_compute(Frame& F, const ConvRegs& R, const LAS float* tdt, const LAS float* tacs) {
    const int ck = F.lane, seg = F.wave;
    if (STATE && ck >= 48) return;
    int pitch, ccol, loff;
    if (ck < 32) { pitch = XPN; ccol = ck * 8; loff = L_X; }
    else if (ck < 48) { pitch = BPN; ccol = (ck - 32) * 8; loff = L_B; }
    else { pitch = BPN; ccol = (ck - 48) * 8; loff = L_C; }
    LAS bf16* dst = (LAS bf16*)(F.lds + loff);
    const int hh = ck >> 3;
#pragma unroll
    for (int i = 0; i < 16; ++i) { const int sr = seg * 16 + i; float o[8];
#pragma unroll
        for (int e = 0; e < 8; ++e) { float a = R.bb[e];
#pragma unroll
            for (int k = 0; k < 4; ++k) a += R.wk[k][e] * bf2f((bf16)R.v[i + k][e]);
            o[e] = silu_f(a); }
        if (STATE && ck < 32) { const float sc = tdt[hh * 128 + sr] * __expf(tacs[hh * 128 + 127] - tacs[hh * 128 + sr]);
#pragma unroll
            for (int e = 0; e < 8; ++e) o[e] *= sc; }
        u32x4 wv; wv.x = pk2(o[0], o[1]); wv.y = pk2(o[2], o[3]); wv.z = pk2(o[4], o[5]); wv.w = pk2(o[6], o[7]);
        *(LAS u32x4*)(dst + sr * pitch + ccol) = wv; }
}
DI void ssd_front(Frame& F, int item, f32x16 (&yd)[2][2]) {
    const bf16* proj = (const bf16*)(F.ws + WS_PROJ); float* ST = F.out; float* CD = (float*)(F.ws + WS_CD);
    const LAS bf16* Xs = (const LAS bf16*)(F.lds + L_X); const LAS bf16* Bs = (const LAS bf16*)(F.lds + L_B); const LAS bf16* Cs = (const LAS bf16*)(F.lds + L_C);
    LAS float* tdt = (LAS float*)(F.lds + L_TDT); LAS float* tacs = (LAS float*)(F.lds + L_TACS); LAS float* tw = (LAS float*)(F.lds + L_RED);
    const int b = item >> 6, c = (item >> 2) & 15, g = item & 3, row0 = b * SEQ + c * 128, l00 = c * 128;
    const int lane = F.lane, r32 = lane & 31, hi = lane >> 5, w = F.wave;
    ConvRegs cr; conv_issue<false>(F, proj, row0, l00, g, cr);
    ssd_tables(F, row0, g, tdt, tacs);
    { const int t = F.tid; tw[t] = tdt[t] * __expf(tacs[(t & ~127) + 127] - tacs[t]); }
    conv_compute<false>(F, cr, tdt, tacs);
    __syncthreads();
    const int hh = w >> 1, h = g * 4 + hh;
    {
        const int pt = w & 1;
        f32x16 acc[4];
#pragma unroll
        for (int nt = 0; nt < 4; ++nt)
#pragma unroll
            for (int i = 0; i < 16; ++i) acc[nt][i] = 0.f;
#pragma unroll
        for (int ks = 0; ks < 8; ++ks) { const bf16x8 ax = tr_frag(Xs, XPN, 16 * ks + 8 * hi, 16 * ks + 8 * hi + 4, hh * 64 + pt * 32, lane);
            const f32x4 w0 = *(const LAS f32x4*)(tw + hh * 128 + 16 * ks + 8 * hi), w1 = *(const LAS f32x4*)(tw + hh * 128 + 16 * ks + 8 * hi + 4);
            u32x4 pa; pa.x = pk2(bf2f((bf16)ax[0]) * w0[0], bf2f((bf16)ax[1]) * w0[1]); pa.y = pk2(bf2f((bf16)ax[2]) * w0[2], bf2f((bf16)ax[3]) * w0[3]);
            pa.z = pk2(bf2f((bf16)ax[4]) * w1[0], bf2f((bf16)ax[5]) * w1[1]); pa.w = pk2(bf2f((bf16)ax[6]) * w1[2], bf2f((bf16)ax[7]) * w1[3]);
            const bf16x8 af = __builtin_bit_cast(bf16x8, pa);
#pragma unroll
            for (int nt = 0; nt < 4; ++nt) { const bf16x8 bfr = tr_frag(Bs, BPN, 16 * ks + 8 * hi, 16 * ks + 8 * hi + 4, nt * 32, lane); acc[nt] = MFMA32(af, bfr, acc[nt]); } }
        float* stp = ST + (size_t)((b * 16 + c) * 16 + h) * 8192;
#pragma unroll
        for (int nt = 0; nt < 4; ++nt)
#pragma unroll
            for (int i = 0; i < 16; ++i) stp[(pt * 32 + crow(i, hi)) * 128 + nt * 32 + r32] = acc[nt][i];
        if (F.tid < 4) CD[(b * 16 + c) * 16 + g * 4 + F.tid] = __expf(tacs[F.tid * 128 + 127]);
    }
    const int pr = w & 1;
#pragma unroll
    for (int li = 0; li < 2; ++li) {
        const int lt = (li == 0) ? pr : 3 - pr, l = lt * 32 + r32;
        bf16x8 cf[8];
#pragma unroll
        for (int ks = 0; ks < 8; ++ks) cf[ks] = *(const LAS bf16x8*)(Cs + l * BPN + 16 * ks + 8 * hi);
        f32x16 acc[2];
#pragma unroll
        for (int pt = 0; pt < 2; ++pt)
#pragma unroll
            for (int i = 0; i < 16; ++i) acc[pt][i] = 0.f;
        const float al = tacs[hh * 128 + l];
#pragma unroll 1
        for (int st = 0; st <= lt; ++st) {
            f32x16 gT;
#pragma unroll
            for (int i = 0; i < 16; ++i) gT[i] = 0.f;
#pragma unroll
            for (int ks = 0; ks < 8; ++ks) { const bf16x8 bfr = *(const LAS bf16x8*)(Bs + (st * 32 + r32) * BPN + 16 * ks + 8 * hi); gT = MFMA32(bfr, cf[ks], gT); }
#pragma unroll
            for (int i = 0; i < 16; ++i) { const int s = st * 32 + crow(i, hi); const float v = gT[i] * __expf(al - tacs[hh * 128 + s]) * tdt[hh * 128 + s]; gT[i] = (s > l) ? 0.f : v; }
#pragma unroll
            for (int s2 = 0; s2 < 2; ++s2) { const bf16x8 mf = pack8(gT, s2);
#pragma unroll
                for (int pt = 0; pt < 2; ++pt) { const bf16x8 xa = tr_frag(Xs, XPN, st * 32 + 16 * s2 + 4 * hi, st * 32 + 16 * s2 + 4 * hi + 8, hh * 64 + pt * 32, lane); acc[pt] = MFMA32(xa, mf, acc[pt]); } }
        }
        yd[li][0] = acc[0]; yd[li][1] = acc[1];
        __builtin_amdgcn_sched_barrier(0);
    }
}
DI void ssd_scan(Frame& F) {
    const float* ST = F.out; const float* CD = (const float*)(F.ws + WS_CD); bf16* PREV = (bf16*)(F.ws + WS_PREV);
    for (int idx = F.blk * 512 + F.tid; idx < NBATCH * NH * 64 * 32; idx += F.G * 512) {
        const int n4 = idx & 31, p = (idx >> 5) & 63, h = (idx >> 11) & 15, b = idx >> 15;
        const size_t base0 = (size_t)(b * 256 + h) * 8192 + p * 128 + n4 * 4;
        f32x4 sv[15]; float d[15];
#pragma unroll
        for (int c = 0; c < 15; ++c) { sv[c] = __builtin_nontemporal_load((const f32x4*)(ST + base0 + (size_t)c * 16 * 8192)); d[c] = CD[(b * 16 + c) * 16 + h]; }
        f32x4 st = {0.f, 0.f, 0.f, 0.f};
#pragma unroll
        for (int c = 0; c < 16; ++c) { u32x2 wv; wv.x = pk2(st[0], st[1]); wv.y = pk2(st[2], st[3]); *(u32x2*)(PREV + base0 + (size_t)c * 16 * 8192) = wv;
            if (c < 15) st = st * d[c] + sv[c]; }
    }
}
DI void ssd_back(Frame& F, int item, f32x16 (&yd)[2][2]) {
    const bf16* proj = (const bf16*)(F.ws + WS_PROJ); bf16* Y = (bf16*)(F.ws + WS_Y); const bf16* PREV = (const bf16*)(F.ws + WS_PREV);
    const LAS bf16* Xs = (const LAS bf16*)(F.lds + L_X); const LAS bf16* Cs = (const LAS bf16*)(F.lds + L_C);
    LAS float* tacs = (LAS float*)(F.lds + L_TACS); LAS float* red = (LAS float*)(F.lds + L_RED);
    const int b = item >> 6, c = (item >> 2) & 15, g = item & 3, row0 = b * SEQ + c * 128;
    const int lane = F.lane, r32 = lane & 31, hi = lane >> 5, w = F.wave;
    const int hh = w >> 1, pr = w & 1, h = g * 4 + hh;
    const bf16* prevp = PREV + (size_t)((b * 16 + c) * 16 + h) * 8192;
    const float Dk = F.D_skip[h];
    bf16x8 pf[2][8];
#pragma unroll
    for (int ks = 0; ks < 8; ++ks)
#pragma unroll
        for (int pt = 0; pt < 2; ++pt) pf[pt][ks] = *(const bf16x8*)(prevp + (pt * 32 + r32) * 128 + 16 * ks + 8 * hi);
#pragma unroll
    for (int li = 0; li < 2; ++li) {
        const int lt = (li == 0) ? pr : 3 - pr, l = lt * 32 + r32;
        u32x2 zz[2][4];
#pragma unroll
        for (int pt = 0; pt < 2; ++pt)
#pragma unroll
            for (int i4 = 0; i4 < 4; ++i4) zz[pt][i4] = __builtin_nontemporal_load((const u32x2*)(proj + (size_t)(row0 + l) * NPROJ + PZ + h * 64 + pt * 32 + 8 * i4 + 4 * hi));
        f32x16 acc[2];
#pragma unroll
        for (int pt = 0; pt < 2; ++pt)
#pragma unroll
            for (int i = 0; i < 16; ++i) acc[pt][i] = 0.f;
#pragma unroll
        for (int ks = 0; ks < 8; ++ks) { const bf16x8 cfk = *(const LAS bf16x8*)(Cs + l * BPN + 16 * ks + 8 * hi);
#pragma unroll
            for (int pt = 0; pt < 2; ++pt) acc[pt] = MFMA32(pf[pt][ks], cfk, acc[pt]); }
        const float el = __expf(tacs[hh * 128 + l]);
        float ss = 0.f;
#pragma unroll
        for (int pt = 0; pt < 2; ++pt)
#pragma unroll
            for (int i4 = 0; i4 < 4; ++i4) { const int p0 = pt * 32 + 8 * i4 + 4 * hi;
                const u32x2 xx = *(const LAS u32x2*)(Xs + l * XPN + hh * 64 + p0);
                const float z[4] = {__uint_as_float(zz[pt][i4].x << 16), __uint_as_float(zz[pt][i4].x & 0xffff0000u), __uint_as_float(zz[pt][i4].y << 16), __uint_as_float(zz[pt][i4].y & 0xffff0000u)};
                const float xv[4] = {__uint_as_float(xx.x << 16), __uint_as_float(xx.x & 0xffff0000u), __uint_as_float(xx.y << 16), __uint_as_float(xx.y & 0xffff0000u)};
#pragma unroll
                for (int e = 0; e < 4; ++e) { const float y = (yd[li][pt][4 * i4 + e] + el * acc[pt][4 * i4 + e] + Dk * xv[e]) * silu_f(z[e]); yd[li][pt][4 * i4 + e] = y; ss += y * y; } }
        ss += __shfl_xor(ss, 32);
        if (hi == 0) red[hh * 128 + l] = ss;
        __builtin_amdgcn_sched_barrier(0);
    }
    __syncthreads();
    LAS bf16* stg = (LAS bf16*)F.lds + w * (64 * 72);
#pragma unroll
    for (int li = 0; li < 2; ++li) {
        const int lt = (li == 0) ? pr : 3 - pr, l = lt * 32 + r32;
        const float rstd = rsqrtf(((red[l] + red[128 + l]) + (red[256 + l] + red[384 + l])) * (1.f / 256.f) + EPS);
#pragma unroll
        for (int pt = 0; pt < 2; ++pt)
#pragma unroll
            for (int i4 = 0; i4 < 4; ++i4) { const int cl = pt * 32 + 8 * i4 + 4 * hi; const f32x4 gg = *(const f32x4*)(F.ssm_g + h * 64 + cl);
                u32x2 wv; wv.x = pk2(yd[li][pt][4 * i4 + 0] * rstd * gg[0], yd[li][pt][4 * i4 + 1] * rstd * gg[1]); wv.y = pk2(yd[li][pt][4 * i4 + 2] * rstd * gg[2], yd[li][pt][4 * i4 + 3] * rstd * gg[3]);
                *(LAS u32x2*)(stg + (li * 32 + r32) * 72 + cl) = wv; }
    }
    asm volatile("s_waitcnt lgkmcnt(0)" ::: "memory");
#pragma unroll
    for (int it = 0; it < 8; ++it) { const int row = it * 8 + (lane >> 3), ch = lane & 7;
        const int lt = (row < 32) ? pr : 3 - pr, l = lt * 32 + (row & 31);
        const u32x4 v = *(const LAS u32x4*)(stg + row * 72 + ch * 8);
        *(u32x4*)(Y + (size_t)(row0 + l) * D + h * 64 + ch * 8) = v; }
    __syncthreads();
}

#define XB_TMO      128
#define XB_XCNT(j)  (256  + 64 * (j))
#define XB_XSUB(j)  (1280 + 64 * (j))
#define XB_XGEN(j)  (2304 + 64 * (j))
#define XB_TOP      3328
#define XB_TOPGEN   3392
#define XCD_BAR_WORDS 3456
#define XB_SPIN_CAP (1u << 18)
DI unsigned xb_ld(unsigned* p)              { return __hip_atomic_load(p, __ATOMIC_RELAXED, __HIP_MEMORY_SCOPE_AGENT); }
DI unsigned xb_add(unsigned* p, unsigned v) { return __hip_atomic_fetch_add(p, v, __ATOMIC_RELAXED, __HIP_MEMORY_SCOPE_AGENT); }
DI unsigned xb_xcc_id() { return (unsigned)__builtin_amdgcn_s_getreg((3 << 11) | 20) & 0xFu; }
#define XB_SPIN(cond, bar) do { unsigned _sp = 0; while (cond) { __builtin_amdgcn_s_sleep(1); \
    if ((++_sp & 255u) == 0u) { if (xb_ld(&(bar)[XB_TMO])) break; if (_sp > XB_SPIN_CAP) { atomicAdd(&(bar)[XB_TMO], 1u); break; } } } } while (0)
struct XcdBarrier { unsigned* bar; unsigned x; volatile LAS unsigned* st; };
DI XcdBarrier xcd_barrier_post(unsigned* bar, volatile LAS unsigned* st) {
    XcdBarrier b; b.bar = bar; b.x = xb_xcc_id(); b.st = st;
    if (threadIdx.x == 0) (void)xb_add(&bar[XB_XCNT(b.x)], 1u);
    return b;
}
DI void xcd_barrier_complete(unsigned* bar, unsigned x, unsigned& nloc, unsigned& nx) {
    const unsigned G = gridDim.x * gridDim.y * gridDim.z;
    unsigned sum, cnt, mine, sp = 0u;
    for (;;) {
        sum = 0u; cnt = 0u; mine = 0u;
#pragma unroll
        for (unsigned j = 0; j < 16; ++j) { const unsigned c = xb_ld(&bar[XB_XCNT(j)]); sum += c; cnt += (c > 0u) ? 1u : 0u; mine = (j == x) ? c : mine; }
        if (sum == G) break;
        __builtin_amdgcn_s_sleep(1);
        if ((++sp & 255u) == 0u) { if (xb_ld(&bar[XB_TMO])) break; if (sp > XB_SPIN_CAP) { atomicAdd(&bar[XB_TMO], 1u); break; } }
    }
    nloc = mine > 0u ? mine : 1u; nx = cnt > 0u ? cnt : 1u;
}
DI void xcd_barrier(const XcdBarrier& b) {
    asm volatile("s_waitcnt vmcnt(0)" ::: "memory");
    __syncthreads();
    if (threadIdx.x == 0) {
        unsigned* bar = b.bar;
        __builtin_amdgcn_s_waitcnt(0);
        unsigned nloc = b.st[0], nx = b.st[1];
        if (nloc == 0u) { xcd_barrier_complete(bar, b.x, nloc, nx); b.st[0] = nloc; b.st[1] = nx; }
        const unsigned old = xb_add(&bar[XB_XSUB(b.x)], 1u);
        const unsigned gen = old / nloc;
        if (old + 1u == (gen + 1u) * nloc) {
            __builtin_amdgcn_fence(__ATOMIC_RELEASE, "agent");
            asm volatile("s_waitcnt vmcnt(0)" ::: "memory");
            const unsigned og = xb_add(&bar[XB_TOP], 1u);
            const unsigned tg = og / nx;
            if (og + 1u == (tg + 1u) * nx) xb_add(&bar[XB_TOPGEN], 1u);
            else XB_SPIN(xb_ld(&bar[XB_TOPGEN]) == tg, bar);
            __builtin_amdgcn_fence(__ATOMIC_ACQUIRE, "agent");
            xb_add(&bar[XB_XGEN(b.x)], 1u);
            asm volatile("s_waitcnt vmcnt(0)" ::: "memory");
        } else {
            XB_SPIN(xb_ld(&bar[XB_XGEN(b.x)]) == gen, bar);
            __builtin_amdgcn_fence(__ATOMIC_ACQUIRE, "agent");
            asm volatile("s_waitcnt vmcnt(0)" ::: "memory");
        }
    }
    __syncthreads();
}

__global__ void __launch_bounds__(512, 2) mk_fwd(Args args) {
    extern __shared__ __attribute__((aligned(16))) unsigned char lds_raw[];
    Frame F;
    F.lds = (LAS unsigned char*)lds_raw;
    F.tid = threadIdx.x; F.lane = F.tid & 63; F.wave = __builtin_amdgcn_readfirstlane(F.tid >> 6); F.G = gridDim.x; F.blk = blockIdx.x;
    F.x = args.in[0]; F.mix_g = args.in[1]; F.w_in = args.in[2]; F.conv_w = args.in[3]; F.conv_b = args.in[4]; F.dt_bias = args.in[5]; F.A_log = args.in[6]; F.D_skip = args.in[7];
    F.ssm_g = args.in[8]; F.sinks = args.in[9]; F.att_g = args.in[10]; F.w_out = args.in[11]; F.mlp_g = args.in[12]; F.w_up = args.in[13]; F.w_down = args.in[14]; F.fin_g = args.in[15];
    F.out = args.out; F.ws = args.ws;
    bf16* XN = (bf16*)(F.ws + WS_XN); bf16* PROJ = (bf16*)(F.ws + WS_PROJ); bf16* Y = (bf16*)(F.ws + WS_Y); bf16* H = (bf16*)(F.ws + WS_H);
    float* SSQ1 = (float*)(F.ws + WS_SSQ1); float* SSQ2 = (float*)(F.ws + WS_SSQ2);
    if (F.tid < 16) ((LAS unsigned*)(F.lds + MISC_OFF))[F.tid] = 0u;
    __syncthreads();
    const XcdBarrier xbar = xcd_barrier_post((unsigned*)F.ws, (volatile LAS unsigned*)(F.lds + MISC_OFF));
    f32x16 yd[2][2];
#pragma unroll
    for (int a_ = 0; a_ < 2; ++a_)
#pragma unroll
        for (int b_ = 0; b_ < 2; ++b_)
#pragma unroll
            for (int i_ = 0; i_ < 16; ++i_) yd[a_][b_][i_] = 0.f;
    const int lo = args.ph_lo, hi = args.ph_hi;
    if (hi > 1000) cg::this_grid().sync();
#define IN(k) (lo <= (k) && (k) < hi)
#define SEAM(k) do { if (IN(k) && IN((k) + 1)) { xcd_barrier(xbar); } } while (0)
#define PH0() if (IN(0)) { p0_prologue(F); } SEAM(0);
#define PH1() if (IN(1)) { \
        pg8::Gemm g{XN, (const bf16*)(F.ws + WS_WIN), M, NPROJ, D}; pg8::StaticOrder S; S.init(M, NPROJ, F.G, F.blk); S.rebal = (F.G == 256) ? 1 : 0; \
        pg8::Epi<0> E{PROJ, NPROJ, nullptr, nullptr, nullptr, (const float*)(F.ws + WS_RS0), nullptr}; \
        pg8::gemm_phase(F.lds, g, S, E); \
        dt_gemm(F); p0b_weights(F); } SEAM(1);
#define PH2() if (IN(2)) { if (F.blk < 256) { attn_item(F, F.blk); if (MK_PROBE_PHASE == 21) attn_item(F, F.blk); ssd_front(F, F.blk, yd); } } SEAM(2); \
    if (MK_PROBE_PHASE == 30) { for (int q_ = 0; q_ < 10; ++q_) xcd_barrier(xbar); } \
    if (IN(3)) { ssd_scan(F); } SEAM(3); \
    if (IN(4)) { if (F.blk < 256) ssd_back(F, F.blk, yd); } SEAM(4);
#define PH5() if (IN(5)) { \
        pg8::Gemm g{Y, (const bf16*)(F.ws + WS_WOUT), M, D, D}; pg8::StaticOrder S; S.init(M, D, F.G, F.blk); \
        pg8::Epi<1> E{XN, D, nullptr, nullptr, SSQ1, nullptr, nullptr}; \
        pg8::gemm_phase(F.lds, g, S, E); } SEAM(5);
#define PH6() if (IN(6)) { \
        pg8::Gemm g{XN, (const bf16*)(F.ws + WS_WUP), M, FF, D}; pg8::StaticOrder S; S.init(M, FF, F.G, F.blk); \
        pg8::Epi<2> E{H, FF, nullptr, nullptr, nullptr, SSQ1, nullptr}; \
        pg8::gemm_phase(F.lds, g, S, E); } SEAM(6);
    PH0();
#if MK_PROBE_PHASE == 0
    PH0();
#endif
    PH1();
#if MK_PROBE_PHASE == 1
    PH1();
#endif
    PH2();
#if MK_PROBE_PHASE == 2
    PH2();
#endif
    PH5();
#if MK_PROBE_PHASE == 5
    PH5();
#endif
    PH6();
#if MK_PROBE_PHASE == 6
    PH6();
#endif
#define PH7() if (IN(7)) { \
        pg8::Gemm g{H, (const bf16*)(F.ws + WS_WDN), M, D, FF}; pg8::StaticOrder S; S.init(M, D, F.G, F.blk); \
        pg8::Epi<3> E{XN, D, F.fin_g, F.out, SSQ2, nullptr, (unsigned*)F.ws + 4096}; \
        pg8::gemm_phase(F.lds, g, S, E); }
    PH7();
#if MK_PROBE_PHASE == 7
    xcd_barrier(xbar);
    PH7();
#endif
}


extern "C" void kernel_launch(void* const* d_in, const int* in_sizes, int n_in, void* d_out, int out_size, void* d_ws, size_t ws_size, hipStream_t stream) {
    static int grid = 0;
    if (grid == 0) {
        int dev = 0, cus = 0, per_cu = 0;
        (void)hipGetDevice(&dev); (void)hipDeviceGetAttribute(&cus, hipDeviceAttributeMultiprocessorCount, dev);
        if (hipFuncSetAttribute((const void*)mk_fwd, hipFuncAttributeMaxDynamicSharedMemorySize, LDS_BYTES) != hipSuccess) { fprintf(stderr, "hipFuncSetAttribute failed\n"); }
        if (hipOccupancyMaxActiveBlocksPerMultiprocessor(&per_cu, (const void*)mk_fwd, 512, LDS_BYTES) != hipSuccess || per_cu < 1) per_cu = 1;
        (void)hipGetLastError();
        if (per_cu > 1) per_cu = 1;
        grid = cus * per_cu;
        if (grid <= 0) grid = 256;
        if (grid != 256) fprintf(stderr, "kernel_launch: grid %d != 256: the fused final norm needs one down-GEMM unit per workgroup\n", grid);
    }
    Args a{};
    for (int i = 0; i < 16; ++i) a.in[i] = (const float*)d_in[i];
    a.out = (float*)d_out; a.ws = (unsigned char*)d_ws;
    a.ph_lo = 0; a.ph_hi = 9;
    (void)hipMemsetAsync(d_ws, 0, 32768, stream);
    void* kargs[] = {&a};
    hipError_t e = hipLaunchCooperativeKernel((const void*)mk_fwd, dim3(grid), dim3(512), kargs, LDS_BYTES, stream);
    if (e != hipSuccess) fprintf(stderr, "cooperative launch failed: %s (grid %d)\n", hipGetErrorString(e), grid);
}
```
